# Optimizing an MI355X kernel written in HIP

```python
import jax
import jax.numpy as jnp
from jax import lax
import numpy as np

D_MODEL = 1024
BATCH = 4
SEQ = 8192
DEPTH = 1

HEAD_DIM = 64
ROPE_THETA = 10000.0
RMS_EPS = 1e-6
Q_BLOCK = 128

A_HEADS = 8
A_KV_HEADS = 2
IDX_HEADS = 4
IDX_DIM = 64
TOPK_MAX = 256

B_PATTERNS = ((128, 1), (512, 4), (2048, 16))
B_N_GROUPS = 3
B_HEADS = 8

MEM_LEN = 256
M_HEADS = 4
M_HEAD_DIM = 128

BRANCH_WIDTH = 512
N_BRANCHES = 3

MOE_GROUPS = 4
EXPERTS_PER_GROUP = 4
N_EXPERTS = 16
MOE_TOPK = 2
EXPERT_HIDDEN = 512

IN_SPLITS = (512, 128, 128, 256, 64, 4, 1536, 1536, 1536, 512)
IN_WIDTH = 6212

kernel_name = 'hybrid_dsa_dilated_memory_hmoe'


def rmsnorm(x, g):
    xf = x.astype(jnp.float32)
    y = xf * lax.rsqrt(jnp.mean(xf * xf, axis=-1, keepdims=True) + RMS_EPS)
    return (y * g.astype(jnp.float32)).astype(x.dtype)


def rope(x):
    s, dh = x.shape[1], x.shape[-1]
    half = dh // 2
    inv = ROPE_THETA ** (-jnp.arange(half, dtype=jnp.float32) / half)
    ang = jnp.arange(s, dtype=jnp.float32)[:, None] * inv[None, :]
    cos = jnp.cos(ang)[None, :, None, :]
    sin = jnp.sin(ang)[None, :, None, :]
    xf = x.astype(jnp.float32)
    x1, x2 = xf[..., :half], xf[..., half:]
    return jnp.concatenate([x1 * cos - x2 * sin, x2 * cos + x1 * sin], axis=-1).astype(x.dtype)


def split_cols(a, sizes):
    out, off = [], 0
    for n in sizes:
        out.append(a[..., off:off + n])
        off += n
    return out


def sweep_query_blocks(fn, seq_len):
    out = lax.map(fn, jnp.arange(seq_len // Q_BLOCK))
    nb, b = out.shape[0], out.shape[1]
    return jnp.moveaxis(out, 0, 1).reshape(b, nb * Q_BLOCK, *out.shape[3:])


def dsa_attention(q, k, v, q_idx, k_idx, w_idx):
    b, s, h, dh = q.shape
    kvh = k.shape[2]
    g = h // kvh
    topk = min(TOPK_MAX, s // 4)
    key_pos = jnp.arange(s)
    local = jnp.arange(Q_BLOCK)
    k_idx_f = k_idx.astype(jnp.float32)

    def block(i):
        q0 = i * Q_BLOCK
        qpos = q0 + local
        qi = lax.dynamic_slice_in_dim(q_idx, q0, Q_BLOCK, axis=1).astype(jnp.float32)
        wi = lax.dynamic_slice_in_dim(w_idx, q0, Q_BLOCK, axis=1).astype(jnp.float32)
        dots = jnp.einsum('bqhd,bsd->bqhs', qi, k_idx_f) * (IDX_DIM ** -0.5)
        score = jnp.einsum('bqhs,bqh->bqs', jax.nn.relu(dots), wi) * (IDX_HEADS ** -0.5)
        causal = key_pos[None, :] <= qpos[:, None]
        score = jnp.where(causal[None], score, -jnp.inf)
        _, sel = lax.top_k(score, topk)
        valid = sel <= qpos[None, :, None]
        ks = jax.vmap(lambda kk, ii: kk[ii])(k, sel)
        vs = jax.vmap(lambda vv, ii: vv[ii])(v, sel)
        qb = lax.dynamic_slice_in_dim(q, q0, Q_BLOCK, axis=1).reshape(b, Q_BLOCK, kvh, g, dh)
        logits = jnp.einsum('bqkgd,bqjkd->bqkgj', qb, ks).astype(jnp.float32) * (dh ** -0.5)
        logits = jnp.where(valid[:, :, None, None, :], logits, -jnp.inf)
        p = jax.nn.softmax(logits, axis=-1)
        o = jnp.einsum('bqkgj,bqjkd->bqkgd', p.astype(vs.dtype), vs)
        return o.reshape(b, Q_BLOCK, h * dh)

    return sweep_query_blocks(block, s)


def dilated_attention(q, k, v):
    b, s, ng, h, dh = q.shape
    local = jnp.arange(Q_BLOCK)
    qs = [q[:, :, gi] for gi in range(ng)]
    kp = [jnp.pad(k[:, :, gi], ((0, 0), (w, 0), (0, 0), (0, 0))) for gi, (w, _) in enumerate(B_PATTERNS)]
    vp = [jnp.pad(v[:, :, gi], ((0, 0), (w, 0), (0, 0), (0, 0))) for gi, (w, _) in enumerate(B_PATTERNS)]

    def block(i):
        q0 = i * Q_BLOCK
        outs, lses = [], []
        for gi, (window, dil) in enumerate(B_PATTERNS):
            steps = jnp.arange(window // dil + 1)
            back = local[:, None] - steps[None, :] * dil
            valid = (q0 + back) >= 0
            rel = window + back
            ks = lax.dynamic_slice_in_dim(kp[gi], q0, window + Q_BLOCK, axis=1)[:, rel]
            vs = lax.dynamic_slice_in_dim(vp[gi], q0, window + Q_BLOCK, axis=1)[:, rel]
            qg = lax.dynamic_slice_in_dim(qs[gi], q0, Q_BLOCK, axis=1)
            logits = jnp.einsum('bqhd,bqjhd->bqhj', qg, ks).astype(jnp.float32) * (dh ** -0.5)
            logits = jnp.where(valid[None, :, None, :], logits, -jnp.inf)
            lse = jax.nn.logsumexp(logits, axis=-1)
            p = jnp.exp(logits - lse[..., None])
            outs.append(jnp.einsum('bqhj,bqjhd->bqhd', p.astype(vs.dtype), vs))
            lses.append(lse)
        alpha = jax.nn.softmax(jnp.stack(lses, axis=2), axis=2)
        o = jnp.einsum('bqgh,bqghd->bqhd', alpha.astype(outs[0].dtype), jnp.stack(outs, axis=2))
        return o.reshape(b, Q_BLOCK, h * dh)

    return sweep_query_blocks(block, s)


def memory_attention(qm, mem_n, w_mem_kv):
    b, m, _ = mem_n.shape
    km, vm = split_cols(mem_n @ w_mem_kv, (M_HEADS * M_HEAD_DIM, M_HEADS * M_HEAD_DIM))
    km = km.reshape(b, m, M_HEADS, M_HEAD_DIM)
    vm = vm.reshape(b, m, M_HEADS, M_HEAD_DIM)
    logits = jnp.einsum('bshd,bmhd->bhsm', qm, km).astype(jnp.float32) * (M_HEAD_DIM ** -0.5)
    p = jax.nn.softmax(logits, axis=-1)
    o = jnp.einsum('bhsm,bmhd->bshd', p.astype(vm.dtype), vm)
    return o.reshape(b, qm.shape[1], M_HEADS * M_HEAD_DIM)


def hier_moe(xn, w_group, b_group, w_sub, b_sub, w1, w3, w2):
    b, s, d = xn.shape
    t = xn.reshape(b * s, d)
    gl = (t @ w_group).astype(jnp.float32) + b_group.astype(jnp.float32)
    gp = jax.nn.softmax(gl, axis=-1)
    g_w, g_sel = lax.top_k(gp, 1)
    sl = jnp.einsum('td,gde->tge', t, w_sub).astype(jnp.float32) + b_sub.astype(jnp.float32)
    sl = jnp.take_along_axis(sl, g_sel[:, :, None], axis=1)[:, 0]
    sp = jax.nn.softmax(sl, axis=-1)
    top_p, top_e = lax.top_k(sp, MOE_TOPK)
    top_p = top_p / jnp.sum(top_p, axis=-1, keepdims=True)
    expert_id = g_sel * EXPERTS_PER_GROUP + top_e
    combine = jnp.einsum('tk,tke->te', g_w * top_p, jax.nn.one_hot(expert_id, N_EXPERTS, dtype=jnp.float32))
    out = jnp.zeros((b * s, d), jnp.float32)
    for e in range(N_EXPERTS):
        hid = jax.nn.silu(t @ w1[e]) * (t @ w3[e])
        out = out + combine[:, e:e + 1] * (hid @ w2[e]).astype(jnp.float32)
    return out.astype(xn.dtype).reshape(b, s, d)


def setup_inputs(seed: int = 0) -> dict:
    key = jax.random.key(seed)
    ks = jax.random.split(key, 19)
    f32 = jnp.float32
    L, D = DEPTH, D_MODEL

    def dense(k, shape, fan_in):
        return jax.random.normal(k, shape, f32) * (fan_in ** -0.5)

    def gain(k, shape):
        return 1.0 + 0.02 * jax.random.normal(k, shape, f32)

    def small(k, shape, scale):
        return scale * jax.random.normal(k, shape, f32)

    return {
        'x': jax.random.normal(ks[0], (BATCH, SEQ, D), f32),
        'mem': jax.random.normal(ks[1], (BATCH, MEM_LEN, D), f32),
        'g_mix': gain(ks[2], (L, D)),
        'g_mem': gain(ks[3], (L, D)),
        'w_in': dense(ks[4], (L, D, IN_WIDTH), D),
        'w_mem_kv': dense(ks[5], (L, D, 2 * M_HEADS * M_HEAD_DIM), D),
        'w_gate': dense(ks[6], (L, D, N_BRANCHES * D), D),
        'b_gate': small(ks[7], (L, N_BRANCHES * D), 0.1),
        'w_branch': dense(ks[8], (L, N_BRANCHES, BRANCH_WIDTH, D), BRANCH_WIDTH),
        'w_out': dense(ks[9], (L, D, D), D),
        'g_ffn': gain(ks[10], (L, D)),
        'w_group': dense(ks[11], (L, D, MOE_GROUPS), D),
        'b_group': small(ks[12], (L, MOE_GROUPS), 0.01),
        'w_sub': dense(ks[13], (L, MOE_GROUPS, D, EXPERTS_PER_GROUP), D),
        'b_sub': small(ks[14], (L, MOE_GROUPS, EXPERTS_PER_GROUP), 0.01),
        'w1': dense(ks[15], (L, N_EXPERTS, D, EXPERT_HIDDEN), D),
        'w3': dense(ks[16], (L, N_EXPERTS, D, EXPERT_HIDDEN), D),
        'w2': dense(ks[17], (L, N_EXPERTS, EXPERT_HIDDEN, D), EXPERT_HIDDEN),
        'g_final': gain(ks[18], (D,)),
    }


def reference(x, mem, g_mix, g_mem, w_in, w_mem_kv, w_gate, b_gate, w_branch, w_out, g_ffn,
              w_group, b_group, w_sub, b_sub, w1, w3, w2, g_final):
    b, s, d = x.shape
    h = x
    for l in range(DEPTH):
        n = rmsnorm(h, g_mix[l])
        aq, ak, av, iq, ik, iw, bq, bk, bv, mq = split_cols(n @ w_in[l], IN_SPLITS)
        aq = rope(aq.reshape(b, s, A_HEADS, HEAD_DIM))
        ak = rope(ak.reshape(b, s, A_KV_HEADS, HEAD_DIM))
        av = av.reshape(b, s, A_KV_HEADS, HEAD_DIM)
        iq = rope(iq.reshape(b, s, IDX_HEADS, IDX_DIM))
        ik = rope(ik.reshape(b, s, 1, IDX_DIM))[:, :, 0]
        y_a = dsa_attention(aq, ak, av, iq, ik, iw)
        bq = rope(bq.reshape(b, s, B_N_GROUPS * B_HEADS, HEAD_DIM)).reshape(b, s, B_N_GROUPS, B_HEADS, HEAD_DIM)
        bk = rope(bk.reshape(b, s, B_N_GROUPS * B_HEADS, HEAD_DIM)).reshape(b, s, B_N_GROUPS, B_HEADS, HEAD_DIM)
        bv = bv.reshape(b, s, B_N_GROUPS, B_HEADS, HEAD_DIM)
        y_b = dilated_attention(bq, bk, bv)
        y_m = memory_attention(mq.reshape(b, s, M_HEADS, M_HEAD_DIM), rmsnorm(mem, g_mem[l]), w_mem_kv[l])
        gates = jax.nn.sigmoid((n @ w_gate[l] + b_gate[l]).astype(jnp.float32)).astype(n.dtype)
        gates = gates.reshape(b, s, N_BRANCHES, d)
        merged = (gates[:, :, 0] * (y_a @ w_branch[l, 0])
                  + gates[:, :, 1] * (y_b @ w_branch[l, 1])
                  + gates[:, :, 2] * (y_m @ w_branch[l, 2]))
        h = h + merged @ w_out[l]
        h = h + hier_moe(rmsnorm(h, g_ffn[l]), w_group[l], b_group[l], w_sub[l], b_sub[l], w1[l], w3[l], w2[l])
    return rmsnorm(h, g_final)
```

```cpp
#include <hip/hip_runtime.h>
#include <stdint.h>
#include <stdio.h>

#define DEV __device__ __forceinline__
typedef unsigned short bf16_t;
typedef short bf16x8 __attribute__((ext_vector_type(8)));
typedef float f32x4 __attribute__((ext_vector_type(4)));
typedef float f32x2 __attribute__((ext_vector_type(2)));
typedef unsigned u32x4 __attribute__((ext_vector_type(4)));
typedef unsigned u32x2 __attribute__((ext_vector_type(2)));
typedef __bf16 bf16x2_t __attribute__((ext_vector_type(2)));

DEV float bf2f(bf16_t v) { return __uint_as_float(((unsigned)v) << 16); }
DEV unsigned pk2(float lo, float hi) { f32x2 v = {lo, hi}; bf16x2_t b = __builtin_convertvector(v, bf16x2_t); return __builtin_bit_cast(unsigned, b); }
DEV bf16_t f2bf(float f) { return (bf16_t)(pk2(f, 0.f) & 0xFFFFu); }
DEV u32x2 pk4(f32x4 v) { u32x2 r; r.x = pk2(v[0], v[1]); r.y = pk2(v[2], v[3]); return r; }
DEV f32x4 unpk4(u32x2 r) { f32x4 v; v[0] = __uint_as_float(r.x << 16); v[1] = __uint_as_float(r.x & 0xFFFF0000u); v[2] = __uint_as_float(r.y << 16); v[3] = __uint_as_float(r.y & 0xFFFF0000u); return v; }
DEV float wave_sum(float v) {
#pragma unroll
  for (int o = 32; o >= 1; o >>= 1) v += __shfl_xor(v, o);
  return v;
}

constexpr int NB = 4, S = 8192, T = NB * S, D = 1024;
constexpr int INW = 6212;
constexpr float RMS_EPS = 1e-6f;
constexpr int C_AQ = 0, C_AK = 512, C_AV = 640, C_IQ = 768, C_IK = 1024, C_BQ = 1088, C_BK = 2624, C_BV = 4160, C_MQ = 5696, C_IW = 6208, C_END = 6212;

constexpr size_t MiB = 1048576;
constexpr size_t OFF_BAR = 0;
constexpr size_t OFF_CNT = 16384;
constexpr size_t OFF_WIN = 1 * MiB;
constexpr size_t OFF_WG = OFF_WIN + 13 * MiB;
constexpr size_t OFF_WB = OFF_WG + 6 * MiB;
constexpr size_t OFF_WO = OFF_WB + 3 * MiB;
constexpr size_t OFF_WM = OFF_WO + 2 * MiB;
constexpr size_t OFF_W13 = OFF_WM + 2 * MiB;
constexpr size_t OFF_W2 = OFF_W13 + 32 * MiB;
constexpr size_t OFF_ROPE = OFF_W2 + 16 * MiB;
constexpr size_t OFF_MEMN = OFF_ROPE + 2 * MiB;
constexpr size_t OFF_KV = OFF_MEMN + 2 * MiB;
constexpr size_t OFF_LIST = OFF_KV + 2 * MiB;
constexpr size_t OFF_CW = OFF_LIST + 2 * MiB;
constexpr size_t OFF_IW = OFF_CW + 1 * MiB;
constexpr size_t OFF_LSE = OFF_IW + 1 * MiB;
constexpr size_t OFF_SEL = OFF_LSE + 3 * MiB;
constexpr size_t OFF_AQ = OFF_SEL + 16 * MiB;
constexpr size_t OFF_AK = OFF_AQ + 32 * MiB;
constexpr size_t OFF_AV = OFF_AK + 8 * MiB;
constexpr size_t OFF_IQ = OFF_AV + 8 * MiB;
constexpr size_t OFF_IK = OFF_IQ + 16 * MiB;
constexpr size_t OFF_BQ = OFF_IK + 4 * MiB;
constexpr size_t OFF_MQ = OFF_BQ + 96 * MiB;
constexpr size_t OFF_BK = OFF_MQ + 32 * MiB;
constexpr size_t OFF_BV = OFF_BK + 96 * MiB;
constexpr size_t OFF_END = OFF_BV + 96 * MiB;
constexpr size_t OFF_YB = OFF_AK, OFF_MERGED = OFF_BQ, OFF_MOE = OFF_BQ, OFF_GATES = OFF_BK, OFF_HN = OFF_BK, OFF_HID = OFF_BK + 64 * MiB;
static_assert(OFF_END <= 512 * MiB, "workspace overflow");

struct Params {
  const float *x, *mem, *g_mix, *g_mem, *w_in, *w_mem_kv, *w_gate, *b_gate, *w_branch, *w_out, *g_ffn, *w_group, *b_group, *w_sub, *b_sub, *w1, *w3, *w2, *g_final;
  float* out;
  char* ws;
};
#define WSP(T_, off) ((T_*)(p.ws + (off)))

__global__ void __launch_bounds__(256) k_prep(Params p) {
  const int lane = threadIdx.x & 63, gw = (blockIdx.x * 256 + threadIdx.x) >> 6, nw = (gridDim.x * 256) >> 6;
  bf16_t* n = (bf16_t*)p.out;
  bf16_t* memn = WSP(bf16_t, OFF_MEMN);
  for (int r = gw; r < T + NB * 256; r += nw) {
    const bool isx = r < T;
    const float* src = isx ? p.x + (size_t)r * D : p.mem + (size_t)(r - T) * D;
    const float* g = isx ? p.g_mix : p.g_mem;
    bf16_t* dst = isx ? n + (size_t)r * D : memn + (size_t)(r - T) * D;
    f32x4 v[4]; float ss = 0.f;
#pragma unroll
    for (int i = 0; i < 4; ++i) { v[i] = *(const f32x4*)(src + i * 256 + lane * 4); ss += v[i][0] * v[i][0] + v[i][1] * v[i][1] + v[i][2] * v[i][2] + v[i][3] * v[i][3]; }
    ss = wave_sum(ss);
    const float rstd = 1.0f / sqrtf(ss * (1.0f / D) + RMS_EPS);
#pragma unroll
    for (int i = 0; i < 4; ++i) { const f32x4 gg = *(const f32x4*)(g + i * 256 + lane * 4); f32x4 o = v[i] * rstd * gg; *(u32x2*)(dst + i * 256 + lane * 4) = pk4(o); }
  }
  f32x2* rope = WSP(f32x2, OFF_ROPE);
  for (int i = blockIdx.x * 256 + threadIdx.x; i < S * 32; i += gridDim.x * 256) {
    const int pos = i >> 5, j = i & 31;
    const double inv = exp2(-(double)j * (13.287712379549449 / 32.0));
    const double ang = (double)pos * inv;
    double rev = ang * 0.15915494309189535; rev -= floor(rev);
    const float rf = (float)rev;
    f32x2 cs; cs.x = __builtin_amdgcn_cosf(rf); cs.y = __builtin_amdgcn_sinf(rf);
    rope[i] = cs;
  }
  if (blockIdx.x == 0 && threadIdx.x < 64) WSP(unsigned, OFF_CNT)[threadIdx.x] = 0u;
}

template <class BV> DEV void dot4x4(f32x4 (&acc)[4], const bf16_t* const (&a)[4], int K, BV bval) {
  for (int k0 = 0; k0 < K; k0 += 8) {
    bf16x8 av[4];
#pragma unroll
    for (int i = 0; i < 4; ++i) av[i] = *(const bf16x8*)(a[i] + k0);
#pragma unroll
    for (int kk = 0; kk < 8; ++kk) {
      const f32x4 b = bval(k0 + kk);
#pragma unroll
      for (int i = 0; i < 4; ++i) acc[i] += bf2f((bf16_t)av[i][kk]) * b;
    }
  }
}

DEV bool g1_dest(const Params& p, int c, bf16_t*& base, int& ld, int& lc, bool& rope) {
  if (c < C_AK) { base = WSP(bf16_t, OFF_AQ); ld = 512; lc = c - C_AQ; rope = true; }
  else if (c < C_AV) { base = WSP(bf16_t, OFF_AK); ld = 128; lc = c - C_AK; rope = true; }
  else if (c < C_IQ) { base = WSP(bf16_t, OFF_AV); ld = 128; lc = c - C_AV; rope = false; }
  else if (c < C_IK) { base = WSP(bf16_t, OFF_IQ); ld = 256; lc = c - C_IQ; rope = true; }
  else if (c < C_BQ) { base = WSP(bf16_t, OFF_IK); ld = 64; lc = c - C_IK; rope = true; }
  else if (c < C_BK) { base = WSP(bf16_t, OFF_BQ); ld = 1536; lc = c - C_BQ; rope = true; }
  else if (c < C_BV) { base = WSP(bf16_t, OFF_BK); ld = 1536; lc = c - C_BK; rope = true; }
  else if (c < C_MQ) { base = WSP(bf16_t, OFF_BV); ld = 1536; lc = c - C_BV; rope = false; }
  else if (c < C_IW) { base = WSP(bf16_t, OFF_MQ); ld = 512; lc = c - C_MQ; rope = false; }
  else return false;
  return true;
}
DEV int src_col(int c) { return c < C_BQ ? c : (c < C_IW ? c + 4 : c - C_IW + 1088); }

__global__ void __launch_bounds__(256) k_n_gemm1(Params p) {
  const bf16_t* n = (const bf16_t*)p.out;
  const f32x2* ropet = WSP(f32x2, OFF_ROPE);
  const int NG = C_END / 4;
  const long items = (long)(T / 4) * NG;
  for (long it = (long)blockIdx.x * 256 + threadIdx.x; it < items; it += (long)gridDim.x * 256) {
    const int ng = (int)(it % NG), mg = (int)(it / NG), c = ng * 4;
    bf16_t* base; int ld, lc; bool rope;
    const bool isbf = g1_dest(p, c, base, ld, lc, rope);
    const bf16_t* a[4];
#pragma unroll
    for (int i = 0; i < 4; ++i) a[i] = n + (size_t)(mg * 4 + i) * D;
    f32x4 acc[4] = {}, pacc[4] = {};
    const float* w = p.w_in + src_col(c);
    dot4x4(acc, a, D, [&](int k) { return *(const f32x4*)(w + (size_t)k * INW); });
    if (isbf && rope) {
      const int pc = ((lc & 63) < 32) ? c + 32 : c - 32;
      const float* w2 = p.w_in + src_col(pc);
      dot4x4(pacc, a, D, [&](int k) { return *(const f32x4*)(w2 + (size_t)k * INW); });
    }
#pragma unroll
    for (int i = 0; i < 4; ++i) {
      const int row = mg * 4 + i;
      if (!isbf) { *(f32x4*)(WSP(float, OFF_IW) + (size_t)row * 4) = acc[i]; continue; }
      f32x4 o = acc[i];
      if (rope) {
        const int pos = row & (S - 1), j = lc & 31; const bool first = (lc & 63) < 32;
#pragma unroll
        for (int e = 0; e < 4; ++e) { const f32x2 cs = ropet[pos * 32 + j + e]; o[e] = first ? acc[i][e] * cs.x - pacc[i][e] * cs.y : acc[i][e] * cs.x + pacc[i][e] * cs.y; }
      }
      *(u32x2*)(base + (size_t)row * ld + lc) = pk4(o);
    }
  }
}

__global__ void __launch_bounds__(256) k_n_memkv(Params p) {
  const bf16_t* memn = WSP(bf16_t, OFF_MEMN); bf16_t* kv = WSP(bf16_t, OFF_KV);
  const long items = (long)(1024 / 4) * 256;
  for (long it = (long)blockIdx.x * 256 + threadIdx.x; it < items; it += (long)gridDim.x * 256) {
    const int ng = (int)(it % 256), mg = (int)(it / 256), c = ng * 4;
    const bf16_t* a[4];
#pragma unroll
    for (int i = 0; i < 4; ++i) a[i] = memn + (size_t)(mg * 4 + i) * D;
    f32x4 acc[4] = {};
    const float* w = p.w_mem_kv + c;
    dot4x4(acc, a, D, [&](int k) { return *(const f32x4*)(w + (size_t)k * 1024); });
#pragma unroll
    for (int i = 0; i < 4; ++i) *(u32x2*)(kv + (size_t)(mg * 4 + i) * 1024 + c) = pk4(acc[i]);
  }
}

DEV unsigned f2key(float s) { const unsigned u = __float_as_uint(s); return (u & 0x80000000u) ? ~u : (u | 0x80000000u); }

__global__ void __launch_bounds__(256) k_n_topk(Params p) {
  __shared__ unsigned long long keys[8192];
  const bf16_t* iq = WSP(bf16_t, OFF_IQ); const bf16_t* ik = WSP(bf16_t, OFF_IK); const float* iw = WSP(float, OFF_IW);
  unsigned short* sel = WSP(unsigned short, OFF_SEL);
  for (int row = blockIdx.x; row < T; row += gridDim.x) {
    const int b = row / S, t = row % S, N = t + 1;
    int P2 = 256; while (P2 < N) P2 <<= 1;
    const float w0 = iw[row * 4 + 0], w1 = iw[row * 4 + 1], w2 = iw[row * 4 + 2], w3 = iw[row * 4 + 3];
    const bf16_t* q = iq + (size_t)row * 256;
    for (int j = threadIdx.x; j < P2; j += 256) {
      unsigned long long key = 0ull;
      if (j < N) {
        const bf16_t* kr = ik + (size_t)(b * S + j) * 64;
        float d0 = 0.f, d1 = 0.f, d2 = 0.f, d3 = 0.f;
        for (int c = 0; c < 64; c += 8) {
          const bf16x8 kk = *(const bf16x8*)(kr + c);
          const bf16x8 q0 = *(const bf16x8*)(q + c), q1 = *(const bf16x8*)(q + 64 + c), q2 = *(const bf16x8*)(q + 128 + c), q3 = *(const bf16x8*)(q + 192 + c);
#pragma unroll
          for (int e = 0; e < 8; ++e) { const float kf = bf2f((bf16_t)kk[e]); d0 += bf2f((bf16_t)q0[e]) * kf; d1 += bf2f((bf16_t)q1[e]) * kf; d2 += bf2f((bf16_t)q2[e]) * kf; d3 += bf2f((bf16_t)q3[e]) * kf; }
        }
        float sc = 0.f;
        sc = fmaf(w0, fmaxf(d0, 0.f), sc); sc = fmaf(w1, fmaxf(d1, 0.f), sc); sc = fmaf(w2, fmaxf(d2, 0.f), sc); sc = fmaf(w3, fmaxf(d3, 0.f), sc);
        sc += 0.0f;
        key = ((unsigned long long)f2key(sc) << 13) | (unsigned long long)(8191 - j);
      }
      keys[j] = key;
    }
    __syncthreads();
    if (N > 256) {
      for (int k = 2; k <= P2; k <<= 1)
        for (int j = k >> 1; j > 0; j >>= 1) {
          for (int i = threadIdx.x; i < P2; i += 256) {
            const int ixj = i ^ j;
            if (ixj > i) {
              const unsigned long long a = keys[i], c = keys[ixj];
              const bool desc = ((i & k) == 0);
              if (desc ? (a < c) : (a > c)) { keys[i] = c; keys[ixj] = a; }
            }
          }
          __syncthreads();
        }
    }
    {
      const int i = threadIdx.x;
      const unsigned long long kk = keys[i];
      sel[(size_t)row * 256 + i] = (i < N && i < 256) ? (unsigned short)(8191 - (int)(kk & 8191ull)) : (unsigned short)0;
    }
    __syncthreads();
  }
}

template <int DH, class KF>
DEV void naive_attn(const bf16_t* q, int nkeys, KF keyf, float scale, bf16_t* out) {
  const int lane = threadIdx.x & 63;
  constexpr int ND = DH / 64;
  float qv[ND], o[ND];
#pragma unroll
  for (int i = 0; i < ND; ++i) { qv[i] = bf2f(q[lane + 64 * i]); o[i] = 0.f; }
  float m = -INFINITY, l = 0.f;
  for (int kk = 0; kk < nkeys; ++kk) {
    const bf16_t *kr, *vr;
    if (!keyf(kk, kr, vr)) continue;
    float d = 0.f;
#pragma unroll
    for (int i = 0; i < ND; ++i) d += qv[i] * bf2f(kr[lane + 64 * i]);
    d = wave_sum(d) * scale;
    const float mn = fmaxf(m, d), f = __expf(m - mn), pe = __expf(d - mn);
    l = l * f + pe;
#pragma unroll
    for (int i = 0; i < ND; ++i) o[i] = o[i] * f + pe * bf2f(vr[lane + 64 * i]);
    m = mn;
  }
  const float inv = 1.0f / l;
#pragma unroll
  for (int i = 0; i < ND; ++i) out[lane + 64 * i] = f2bf(o[i] * inv);
}

__global__ void __launch_bounds__(256) k_n_attn_a(Params p) {
  const int gw = (blockIdx.x * 256 + threadIdx.x) >> 6, nw = (gridDim.x * 256) >> 6;
  bf16_t* aq = WSP(bf16_t, OFF_AQ); const bf16_t* ak = WSP(bf16_t, OFF_AK); const bf16_t* av = WSP(bf16_t, OFF_AV);
  const unsigned short* sel = WSP(unsigned short, OFF_SEL);
  for (int u = gw; u < T * 8; u += nw) {
    const int row = u >> 3, h = u & 7, kvh = h >> 2, b = row / S, t = row % S;
    const int cnt = t + 1 < 256 ? t + 1 : 256;
    bf16_t* q = aq + (size_t)row * 512 + h * 64;
    naive_attn<64>(q, cnt, [&](int kk, const bf16_t*& kr, const bf16_t*& vr) {
      const int j = sel[(size_t)row * 256 + kk]; const size_t r = (size_t)(b * S + j) * 128 + kvh * 64; kr = ak + r; vr = av + r; return true; }, 0.125f, q);
  }
}
__global__ void __launch_bounds__(256) k_n_attn_m(Params p) {
  const int gw = (blockIdx.x * 256 + threadIdx.x) >> 6, nw = (gridDim.x * 256) >> 6;
  bf16_t* mq = WSP(bf16_t, OFF_MQ); const bf16_t* kv = WSP(bf16_t, OFF_KV);
  for (int u = gw; u < T * 4; u += nw) {
    const int row = u >> 2, h = u & 3, b = row / S;
    bf16_t* q = mq + (size_t)row * 512 + h * 128;
    naive_attn<128>(q, 256, [&](int kk, const bf16_t*& kr, const bf16_t*& vr) {
      const size_t r = (size_t)(b * 256 + kk) * 1024 + h * 128; kr = kv + r; vr = kv + r + 512; return true; }, 0.08838834764831845f, q);
  }
}
__global__ void __launch_bounds__(256) k_n_attn_b(Params p) {
  const int gw = (blockIdx.x * 256 + threadIdx.x) >> 6, nw = (gridDim.x * 256) >> 6, lane = threadIdx.x & 63;
  const bf16_t* bq = WSP(bf16_t, OFF_BQ); const bf16_t* bk = WSP(bf16_t, OFF_BK); const bf16_t* bv = WSP(bf16_t, OFF_BV);
  bf16_t* yb = WSP(bf16_t, OFF_YB);
  for (int u = gw; u < T * 8; u += nw) {
    const int row = u >> 3, h = u & 7, t = row % S;
    float o = 0.f, m = -INFINITY, l = 0.f;
#pragma unroll
    for (int g = 0; g < 3; ++g) {
      const int dil = g == 0 ? 1 : (g == 1 ? 4 : 16);
      const float qv = bf2f(bq[(size_t)row * 1536 + (g * 8 + h) * 64 + lane]);
      for (int s = 0; s <= 128; ++s) {
        const int tk = t - s * dil; if (tk < 0) break;
        const size_t r = (size_t)(row - s * dil) * 1536 + (g * 8 + h) * 64 + lane;
        float d = wave_sum(qv * bf2f(bk[r])) * 0.125f;
        const float mn = fmaxf(m, d), f = __expf(m - mn), pe = __expf(d - mn);
        l = l * f + pe; o = o * f + pe * bf2f(bv[r]); m = mn;
      }
    }
    yb[(size_t)row * 512 + h * 64 + lane] = f2bf(o / l);
  }
}

__global__ void __launch_bounds__(256) k_n_gates(Params p) {
  const bf16_t* n = (const bf16_t*)p.out; bf16_t* gates = WSP(bf16_t, OFF_GATES);
  const int NG = 3072 / 4; const long items = (long)(T / 4) * NG;
  for (long it = (long)blockIdx.x * 256 + threadIdx.x; it < items; it += (long)gridDim.x * 256) {
    const int ng = (int)(it % NG), mg = (int)(it / NG), c = ng * 4;
    const bf16_t* a[4];
#pragma unroll
    for (int i = 0; i < 4; ++i) a[i] = n + (size_t)(mg * 4 + i) * D;
    f32x4 acc[4] = {};
    const float* w = p.w_gate + c;
    dot4x4(acc, a, D, [&](int k) { return *(const f32x4*)(w + (size_t)k * 3072); });
    const f32x4 bb = *(const f32x4*)(p.b_gate + c);
#pragma unroll
    for (int i = 0; i < 4; ++i) { f32x4 o; for (int e = 0; e < 4; ++e) o[e] = 1.0f / (1.0f + __expf(-(acc[i][e] + bb[e]))); *(u32x2*)(gates + (size_t)(mg * 4 + i) * 3072 + c) = pk4(o); }
  }
}
__global__ void __launch_bounds__(256) k_n_branch(Params p) {
  const bf16_t* gates = WSP(bf16_t, OFF_GATES); bf16_t* merged = WSP(bf16_t, OFF_MERGED);
  const bf16_t* ys[3] = {WSP(bf16_t, OFF_AQ), WSP(bf16_t, OFF_YB), WSP(bf16_t, OFF_MQ)};
  const int NG = 1024 / 4; const long items = (long)(T / 4) * NG;
  for (long it = (long)blockIdx.x * 256 + threadIdx.x; it < items; it += (long)gridDim.x * 256) {
    const int ng = (int)(it % NG), mg = (int)(it / NG), c = ng * 4;
    f32x4 tot[4] = {};
#pragma unroll
    for (int br = 0; br < 3; ++br) {
      const bf16_t* a[4];
#pragma unroll
      for (int i = 0; i < 4; ++i) a[i] = ys[br] + (size_t)(mg * 4 + i) * 512;
      f32x4 acc[4] = {};
      const float* w = p.w_branch + (size_t)br * 512 * 1024 + c;
      dot4x4(acc, a, 512, [&](int k) { return *(const f32x4*)(w + (size_t)k * 1024); });
#pragma unroll
      for (int i = 0; i < 4; ++i) { const f32x4 g = unpk4(*(const u32x2*)(gates + (size_t)(mg * 4 + i) * 3072 + br * 1024 + c)); tot[i] += g * acc[i]; }
    }
#pragma unroll
    for (int i = 0; i < 4; ++i) *(u32x2*)(merged + (size_t)(mg * 4 + i) * 1024 + c) = pk4(tot[i]);
  }
}
__global__ void __launch_bounds__(256) k_n_out(Params p) {
  const bf16_t* merged = WSP(bf16_t, OFF_MERGED);
  const int NG = 1024 / 4; const long items = (long)(T / 4) * NG;
  for (long it = (long)blockIdx.x * 256 + threadIdx.x; it < items; it += (long)gridDim.x * 256) {
    const int ng = (int)(it % NG), mg = (int)(it / NG), c = ng * 4;
    const bf16_t* a[4];
#pragma unroll
    for (int i = 0; i < 4; ++i) a[i] = merged + (size_t)(mg * 4 + i) * 1024;
    f32x4 acc[4] = {};
    const float* w = p.w_out + c;
    dot4x4(acc, a, D, [&](int k) { return *(const f32x4*)(w + (size_t)k * 1024); });
#pragma unroll
    for (int i = 0; i < 4; ++i) { const size_t o = (size_t)(mg * 4 + i) * 1024 + c; *(f32x4*)(p.out + o) = *(const f32x4*)(p.x + o) + acc[i]; }
  }
}

DEV void route_block(const Params& p, int blk, char* lds) {
  int* tok_e = (int*)lds;
  float* tok_w = (float*)(lds + 512);
  int* lcnt = (int*)(lds + 1024);
  int* gbase = (int*)(lds + 1088);
  int* rank = (int*)(lds + 1152);
  const int tid = threadIdx.x, lane = tid & 63, wid = tid >> 6;
  const float* h1 = p.out; bf16_t* hn = WSP(bf16_t, OFF_HN);
  if (tid < 16) lcnt[tid] = 0;
  for (int g4 = 0; g4 < 4; ++g4) {
    const int tok0 = blk * 64 + wid * 16 + g4 * 4;
    float acc[4][20]; float ss[4];
#pragma unroll
    for (int tk = 0; tk < 4; ++tk) { ss[tk] = 0.f;
#pragma unroll
      for (int j = 0; j < 20; ++j) acc[tk][j] = 0.f; }
    for (int i = 0; i < 16; ++i) {
      const int d = i * 64 + lane;
      float wg[20];
      { const f32x4 a = *(const f32x4*)(p.w_group + (size_t)d * 4); wg[0] = a[0]; wg[1] = a[1]; wg[2] = a[2]; wg[3] = a[3]; }
#pragma unroll
      for (int g = 0; g < 4; ++g) { const f32x4 a = *(const f32x4*)(p.w_sub + ((size_t)g * 1024 + d) * 4); wg[4 + 4 * g] = a[0]; wg[5 + 4 * g] = a[1]; wg[6 + 4 * g] = a[2]; wg[7 + 4 * g] = a[3]; }
      const float gf = p.g_ffn[d];
#pragma unroll
      for (int tk = 0; tk < 4; ++tk) {
        const float xv = h1[(size_t)(tok0 + tk) * D + d]; ss[tk] += xv * xv; const float xg = xv * gf;
#pragma unroll
        for (int j = 0; j < 20; ++j) acc[tk][j] = fmaf(xg, wg[j], acc[tk][j]);
      }
    }
    float rstd[4];
#pragma unroll
    for (int tk = 0; tk < 4; ++tk) { ss[tk] = wave_sum(ss[tk]); rstd[tk] = 1.0f / sqrtf(ss[tk] * (1.0f / D) + RMS_EPS);
#pragma unroll
      for (int j = 0; j < 20; ++j) acc[tk][j] = wave_sum(acc[tk][j]); }
#pragma unroll
    for (int tk = 0; tk < 4; ++tk)
      for (int i = 0; i < 16; ++i) { const int d = i * 64 + lane; hn[(size_t)(tok0 + tk) * D + d] = f2bf(h1[(size_t)(tok0 + tk) * D + d] * rstd[tk] * p.g_ffn[d]); }
#pragma unroll
    for (int tk = 0; tk < 4; ++tk) {
      float gl[4];
#pragma unroll
      for (int g = 0; g < 4; ++g) gl[g] = acc[tk][g] * rstd[tk] + p.b_group[g];
      int gs = 0; float gm = gl[0];
#pragma unroll
      for (int g = 1; g < 4; ++g) if (gl[g] > gm) { gm = gl[g]; gs = g; }
      float gden = 0.f;
#pragma unroll
      for (int g = 0; g < 4; ++g) gden += __expf(gl[g] - gm);
      const float gw = 1.0f / gden;
      float sl[4];
#pragma unroll
      for (int e = 0; e < 4; ++e) { float v = 0.f;
#pragma unroll
        for (int g = 0; g < 4; ++g) v = (gs == g) ? acc[tk][4 + 4 * g + e] * rstd[tk] + p.b_sub[g * 4 + e] : v;
        sl[e] = v; }
      int e0 = 0; float m0 = sl[0];
#pragma unroll
      for (int e = 1; e < 4; ++e) if (sl[e] > m0) { m0 = sl[e]; e0 = e; }
      int e1 = -1; float m1 = -INFINITY;
#pragma unroll
      for (int e = 0; e < 4; ++e) if (e != e0 && sl[e] > m1) { m1 = sl[e]; e1 = e; }
      const float p1 = __expf(m1 - m0);
      const float w0 = gw / (1.0f + p1), w1 = gw * p1 / (1.0f + p1);
      if (lane == 0) { const int tl = wid * 16 + g4 * 4 + tk; tok_e[tl * 2] = gs * 4 + e0; tok_e[tl * 2 + 1] = gs * 4 + e1; tok_w[tl * 2] = w0; tok_w[tl * 2 + 1] = w1; }
    }
  }
  __syncthreads();
  if (tid < 128) rank[tid] = atomicAdd(&lcnt[tok_e[tid]], 1);
  __syncthreads();
  if (tid < 16) gbase[tid] = (int)__hip_atomic_fetch_add(WSP(unsigned, OFF_CNT) + tid, (unsigned)lcnt[tid], __ATOMIC_RELAXED, __HIP_MEMORY_SCOPE_AGENT);
  __syncthreads();
  if (tid < 128) {
    const int e = tok_e[tid], ent = (blk * 64 + (tid >> 1)) * 2 + (tid & 1);
    WSP(int, OFF_LIST)[(size_t)e * T + gbase[e] + rank[tid]] = ent;
    WSP(float, OFF_CW)[ent] = tok_w[tid];
  }
  __syncthreads();
}
__global__ void __launch_bounds__(256) k_route(Params p) {
  __shared__ __attribute__((aligned(16))) char lds[2048];
  for (int blk = blockIdx.x; blk < T / 64; blk += gridDim.x) route_block(p, blk, lds);
}

__global__ void __launch_bounds__(256) k_n_up(Params p) {
  const bf16_t* hn = WSP(bf16_t, OFF_HN); bf16_t* hid = WSP(bf16_t, OFF_HID);
  const unsigned* cnt = WSP(unsigned, OFF_CNT); const int* list = WSP(int, OFF_LIST); const float* cw = WSP(float, OFF_CW);
  const int NG = 512 / 4;
  for (int e = 0; e < 16; ++e) {
    const int ne = (int)cnt[e], mgs = (ne + 3) / 4; const long items = (long)mgs * NG;
    for (long it = (long)blockIdx.x * 256 + threadIdx.x; it < items; it += (long)gridDim.x * 256) {
      const int ng = (int)(it % NG), mg = (int)(it / NG), c = ng * 4;
      const bf16_t* a[4]; int ent[4];
#pragma unroll
      for (int i = 0; i < 4; ++i) { const int r = mg * 4 + i; ent[i] = list[(size_t)e * T + (r < ne ? r : 0)]; a[i] = hn + (size_t)(ent[i] >> 1) * D; }
      f32x4 a1[4] = {}, a3[4] = {};
      const float* w1 = p.w1 + (size_t)e * 1024 * 512 + c; const float* w3 = p.w3 + (size_t)e * 1024 * 512 + c;
      dot4x4(a1, a, D, [&](int k) { return *(const f32x4*)(w1 + (size_t)k * 512); });
      dot4x4(a3, a, D, [&](int k) { return *(const f32x4*)(w3 + (size_t)k * 512); });
#pragma unroll
      for (int i = 0; i < 4; ++i) if (mg * 4 + i < ne) {
        const float cwv = cw[ent[i]]; f32x4 o;
        for (int q = 0; q < 4; ++q) { const float v = a1[i][q]; o[q] = v / (1.0f + __expf(-v)) * a3[i][q] * cwv; }
        *(u32x2*)(hid + (size_t)ent[i] * 512 + c) = pk4(o);
      }
    }
  }
}
__global__ void __launch_bounds__(256) k_n_down(Params p) {
  const bf16_t* hid = WSP(bf16_t, OFF_HID); bf16_t* moe = WSP(bf16_t, OFF_MOE);
  const unsigned* cnt = WSP(unsigned, OFF_CNT); const int* list = WSP(int, OFF_LIST);
  const int NG = 1024 / 4;
  for (int e = 0; e < 16; ++e) {
    const int ne = (int)cnt[e], mgs = (ne + 3) / 4; const long items = (long)mgs * NG;
    for (long it = (long)blockIdx.x * 256 + threadIdx.x; it < items; it += (long)gridDim.x * 256) {
      const int ng = (int)(it % NG), mg = (int)(it / NG), c = ng * 4;
      const bf16_t* a[4]; int ent[4];
#pragma unroll
      for (int i = 0; i < 4; ++i) { const int r = mg * 4 + i; ent[i] = list[(size_t)e * T + (r < ne ? r : 0)]; a[i] = hid + (size_t)ent[i] * 512; }
      f32x4 acc[4] = {};
      const float* w = p.w2 + (size_t)e * 512 * 1024 + c;
      dot4x4(acc, a, 512, [&](int k) { return *(const f32x4*)(w + (size_t)k * 1024); });
#pragma unroll
      for (int i = 0; i < 4; ++i) if (mg * 4 + i < ne) *(u32x2*)(moe + (size_t)ent[i] * 1024 + c) = pk4(acc[i]);
    }
  }
}

__global__ void __launch_bounds__(256) k_final(Params p) {
  const int lane = threadIdx.x & 63, gw = (blockIdx.x * 256 + threadIdx.x) >> 6, nw = (gridDim.x * 256) >> 6;
  const bf16_t* moe = WSP(bf16_t, OFF_MOE);
  for (int r = gw; r < T; r += nw) {
    f32x4 v[4]; float ss = 0.f;
#pragma unroll
    for (int i = 0; i < 4; ++i) {
      const int c = i * 256 + lane * 4;
      v[i] = *(const f32x4*)(p.out + (size_t)r * D + c) + unpk4(*(const u32x2*)(moe + (size_t)(2 * r) * D + c)) + unpk4(*(const u32x2*)(moe + (size_t)(2 * r + 1) * D + c));
      ss += v[i][0] * v[i][0] + v[i][1] * v[i][1] + v[i][2] * v[i][2] + v[i][3] * v[i][3];
    }
    ss = wave_sum(ss);
    const float rstd = 1.0f / sqrtf(ss * (1.0f / D) + RMS_EPS);
#pragma unroll
    for (int i = 0; i < 4; ++i) { const int c = i * 256 + lane * 4; *(f32x4*)(p.out + (size_t)r * D + c) = v[i] * rstd * *(const f32x4*)(p.g_final + c); }
  }
}

extern "C" void kernel_launch(void* const* d_in, const int* in_sizes, int n_in, void* d_out, int out_size, void* d_ws, size_t ws_size, hipStream_t stream) {
  (void)in_sizes; (void)n_in; (void)out_size;
  if (ws_size < OFF_END) { fprintf(stderr, "workspace too small: %zu < %zu\n", ws_size, (size_t)OFF_END); return; }
  Params p{};
  p.x = (const float*)d_in[0]; p.mem = (const float*)d_in[1]; p.g_mix = (const float*)d_in[2]; p.g_mem = (const float*)d_in[3];
  p.w_in = (const float*)d_in[4]; p.w_mem_kv = (const float*)d_in[5]; p.w_gate = (const float*)d_in[6]; p.b_gate = (const float*)d_in[7];
  p.w_branch = (const float*)d_in[8]; p.w_out = (const float*)d_in[9]; p.g_ffn = (const float*)d_in[10]; p.w_group = (const float*)d_in[11];
  p.b_group = (const float*)d_in[12]; p.w_sub = (const float*)d_in[13]; p.b_sub = (const float*)d_in[14]; p.w1 = (const float*)d_in[15];
  p.w3 = (const float*)d_in[16]; p.w2 = (const float*)d_in[17]; p.g_final = (const float*)d_in[18];
  p.out = (float*)d_out; p.ws = (char*)d_ws;
  const int G = 4096;
  k_prep<<<G, 256, 0, stream>>>(p);
  k_n_gemm1<<<G, 256, 0, stream>>>(p);
  k_n_memkv<<<256, 256, 0, stream>>>(p);
  k_n_topk<<<G, 256, 0, stream>>>(p);
  k_n_attn_a<<<G, 256, 0, stream>>>(p);
  k_n_attn_m<<<G, 256, 0, stream>>>(p);
  k_n_attn_b<<<G, 256, 0, stream>>>(p);
  k_n_gates<<<G, 256, 0, stream>>>(p);
  k_n_branch<<<G, 256, 0, stream>>>(p);
  k_n_out<<<G, 256, 0, stream>>>(p);
  k_route<<<512, 256, 0, stream>>>(p);
  k_n_up<<<G, 256, 0, stream>>>(p);
  k_n_down<<<G, 256, 0, stream>>>(p);
  k_final<<<G, 256, 0, stream>>>(p);
}
```

```cpp
#include <hip/hip_runtime.h>
#include <stdint.h>
#include <stdio.h>

#define DEV __device__ __forceinline__
typedef unsigned short bf16_t;
typedef short bf16x8 __attribute__((ext_vector_type(8)));
typedef float f32x4 __attribute__((ext_vector_type(4)));
typedef float f32x2 __attribute__((ext_vector_type(2)));
typedef unsigned u32x4 __attribute__((ext_vector_type(4)));
typedef unsigned u32x2 __attribute__((ext_vector_type(2)));
typedef __bf16 bf16x2_t __attribute__((ext_vector_type(2)));

DEV float bf2f(bf16_t v) { return __uint_as_float(((unsigned)v) << 16); }
DEV unsigned pk2(float lo, float hi) { f32x2 v = {lo, hi}; bf16x2_t b = __builtin_convertvector(v, bf16x2_t); return __builtin_bit_cast(unsigned, b); }
DEV bf16_t f2bf(float f) { return (bf16_t)(pk2(f, 0.f) & 0xFFFFu); }
DEV u32x2 pk4(f32x4 v) { u32x2 r; r.x = pk2(v[0], v[1]); r.y = pk2(v[2], v[3]); return r; }
DEV f32x4 unpk4(u32x2 r) { f32x4 v; v[0] = __uint_as_float(r.x << 16); v[1] = __uint_as_float(r.x & 0xFFFF0000u); v[2] = __uint_as_float(r.y << 16); v[3] = __uint_as_float(r.y & 0xFFFF0000u); return v; }
DEV float wave_sum(float v) {
#pragma unroll
  for (int o = 32; o >= 1; o >>= 1) v += __shfl_xor(v, o);
  return v;
}

constexpr int NB = 4, S = 8192, T = NB * S, D = 1024;
constexpr int INW = 6212;
constexpr float RMS_EPS = 1e-6f;
constexpr int C_AQ = 0, C_AK = 512, C_AV = 640, C_IQ = 768, C_IK = 1024, C_BQ = 1088, C_BK = 2624, C_BV = 4160, C_MQ = 5696, C_IW = 6208, C_END = 6212;

constexpr size_t MiB = 1048576;
constexpr size_t OFF_BAR = 0;
constexpr size_t OFF_CNT = 16384;
constexpr size_t OFF_WIN = 1 * MiB;
constexpr size_t OFF_WG = OFF_WIN + 13 * MiB;
constexpr size_t OFF_WB = OFF_WG + 6 * MiB;
constexpr size_t OFF_WO = OFF_WB + 3 * MiB;
constexpr size_t OFF_WM = OFF_WO + 2 * MiB;
constexpr size_t OFF_W13 = OFF_WM + 2 * MiB;
constexpr size_t OFF_W2 = OFF_W13 + 32 * MiB;
constexpr size_t OFF_ROPE = OFF_W2 + 16 * MiB;
constexpr size_t OFF_MEMN = OFF_ROPE + 2 * MiB;
constexpr size_t OFF_KV = OFF_MEMN + 2 * MiB;
constexpr size_t OFF_LIST = OFF_KV + 2 * MiB;
constexpr size_t OFF_CW = OFF_LIST + 2 * MiB;
constexpr size_t OFF_IW = OFF_CW + 1 * MiB;
constexpr size_t OFF_LSE = OFF_IW + 1 * MiB;
constexpr size_t OFF_SEL = OFF_LSE + 3 * MiB;
constexpr size_t OFF_AQ = OFF_SEL + 16 * MiB;
constexpr size_t OFF_AK = OFF_AQ + 32 * MiB;
constexpr size_t OFF_AV = OFF_AK + 8 * MiB;
constexpr size_t OFF_IQ = OFF_AV + 8 * MiB;
constexpr size_t OFF_IK = OFF_IQ + 16 * MiB;
constexpr size_t OFF_BQ = OFF_IK + 4 * MiB;
constexpr size_t OFF_MQ = OFF_BQ + 96 * MiB;
constexpr size_t OFF_BK = OFF_MQ + 32 * MiB;
constexpr size_t OFF_BV = OFF_BK + 96 * MiB;
constexpr size_t OFF_END = OFF_BV + 96 * MiB;
constexpr size_t OFF_YB = OFF_AK, OFF_MERGED = OFF_BQ, OFF_MOE = OFF_BQ, OFF_GATES = OFF_BK, OFF_HN = OFF_BK, OFF_HID = OFF_BK + 64 * MiB;
static_assert(OFF_END <= 512 * MiB, "workspace overflow");

struct Params {
  const float *x, *mem, *g_mix, *g_mem, *w_in, *w_mem_kv, *w_gate, *b_gate, *w_branch, *w_out, *g_ffn, *w_group, *b_group, *w_sub, *b_sub, *w1, *w3, *w2, *g_final;
  float* out;
  char* ws;
};
#define WSP(T_, off) ((T_*)(p.ws + (off)))

__global__ void __launch_bounds__(256) k_prep(Params p) {
  const int lane = threadIdx.x & 63, gw = (blockIdx.x * 256 + threadIdx.x) >> 6, nw = (gridDim.x * 256) >> 6;
  bf16_t* n = (bf16_t*)p.out;
  bf16_t* memn = WSP(bf16_t, OFF_MEMN);
  for (int r = gw; r < T + NB * 256; r += nw) {
    const bool isx = r < T;
    const float* src = isx ? p.x + (size_t)r * D : p.mem + (size_t)(r - T) * D;
    const float* g = isx ? p.g_mix : p.g_mem;
    bf16_t* dst = isx ? n + (size_t)r * D : memn + (size_t)(r - T) * D;
    f32x4 v[4]; float ss = 0.f;
#pragma unroll
    for (int i = 0; i < 4; ++i) { v[i] = *(const f32x4*)(src + i * 256 + lane * 4); ss += v[i][0] * v[i][0] + v[i][1] * v[i][1] + v[i][2] * v[i][2] + v[i][3] * v[i][3]; }
    ss = wave_sum(ss);
    const float rstd = 1.0f / sqrtf(ss * (1.0f / D) + RMS_EPS);
#pragma unroll
    for (int i = 0; i < 4; ++i) { const f32x4 gg = *(const f32x4*)(g + i * 256 + lane * 4); f32x4 o = v[i] * rstd * gg; *(u32x2*)(dst + i * 256 + lane * 4) = pk4(o); }
  }
  f32x2* rope = WSP(f32x2, OFF_ROPE);
  for (int i = blockIdx.x * 256 + threadIdx.x; i < S * 32; i += gridDim.x * 256) {
    const int pos = i >> 5, j = i & 31;
    const double inv = exp2(-(double)j * (13.287712379549449 / 32.0));
    const double ang = (double)pos * inv;
    double rev = ang * 0.15915494309189535; rev -= floor(rev);
    const float rf = (float)rev;
    f32x2 cs; cs.x = __builtin_amdgcn_cosf(rf); cs.y = __builtin_amdgcn_sinf(rf);
    rope[i] = cs;
  }
  if (blockIdx.x == 0 && threadIdx.x < 64) WSP(unsigned, OFF_CNT)[threadIdx.x] = 0u;
}

template <class BV> DEV void dot4x4(f32x4 (&acc)[4], const bf16_t* const (&a)[4], int K, BV bval) {
  for (int k0 = 0; k0 < K; k0 += 8) {
    bf16x8 av[4];
#pragma unroll
    for (int i = 0; i < 4; ++i) av[i] = *(const bf16x8*)(a[i] + k0);
#pragma unroll
    for (int kk = 0; kk < 8; ++kk) {
      const f32x4 b = bval(k0 + kk);
#pragma unroll
      for (int i = 0; i < 4; ++i) acc[i] += bf2f((bf16_t)av[i][kk]) * b;
    }
  }
}

DEV bool g1_dest(const Params& p, int c, bf16_t*& base, int& ld, int& lc, bool& rope) {
  if (c < C_AK) { base = WSP(bf16_t, OFF_AQ); ld = 512; lc = c - C_AQ; rope = true; }
  else if (c < C_AV) { base = WSP(bf16_t, OFF_AK); ld = 128; lc = c - C_AK; rope = true; }
  else if (c < C_IQ) { base = WSP(bf16_t, OFF_AV); ld = 128; lc = c - C_AV; rope = false; }
  else if (c < C_IK) { base = WSP(bf16_t, OFF_IQ); ld = 256; lc = c - C_IQ; rope = true; }
  else if (c < C_BQ) { base = WSP(bf16_t, OFF_IK); ld = 64; lc = c - C_IK; rope = true; }
  else if (c < C_BK) { base = WSP(bf16_t, OFF_BQ); ld = 1536; lc = c - C_BQ; rope = true; }
  else if (c < C_BV) { base = WSP(bf16_t, OFF_BK); ld = 1536; lc = c - C_BK; rope = true; }
  else if (c < C_MQ) { base = WSP(bf16_t, OFF_BV); ld = 1536; lc = c - C_BV; rope = false; }
  else if (c < C_IW) { base = WSP(bf16_t, OFF_MQ); ld = 512; lc = c - C_MQ; rope = false; }
  else return false;
  return true;
}
DEV int src_col(int c) { return c < C_BQ ? c : (c < C_IW ? c + 4 : c - C_IW + 1088); }

__global__ void __launch_bounds__(256) k_n_gemm1(Params p) {
  const bf16_t* n = (const bf16_t*)p.out;
  const f32x2* ropet = WSP(f32x2, OFF_ROPE);
  const int NG = C_END / 4;
  const long items = (long)(T / 4) * NG;
  for (long it = (long)blockIdx.x * 256 + threadIdx.x; it < items; it += (long)gridDim.x * 256) {
    const int ng = (int)(it % NG), mg = (int)(it / NG), c = ng * 4;
    bf16_t* base; int ld, lc; bool rope;
    const bool isbf = g1_dest(p, c, base, ld, lc, rope);
    const bf16_t* a[4];
#pragma unroll
    for (int i = 0; i < 4; ++i) a[i] = n + (size_t)(mg * 4 + i) * D;
    f32x4 acc[4] = {}, pacc[4] = {};
    const float* w = p.w_in + src_col(c);
    dot4x4(acc, a, D, [&](int k) { return *(const f32x4*)(w + (size_t)k * INW); });
    if (isbf && rope) {
      const int pc = ((lc & 63) < 32) ? c + 32 : c - 32;
      const float* w2 = p.w_in + src_col(pc);
      dot4x4(pacc, a, D, [&](int k) { return *(const f32x4*)(w2 + (size_t)k * INW); });
    }
#pragma unroll
    for (int i = 0; i < 4; ++i) {
      const int row = mg * 4 + i;
      if (!isbf) { *(f32x4*)(WSP(float, OFF_IW) + (size_t)row * 4) = acc[i]; continue; }
      f32x4 o = acc[i];
      if (rope) {
        const int pos = row & (S - 1), j = lc & 31; const bool first = (lc & 63) < 32;
#pragma unroll
        for (int e = 0; e < 4; ++e) { const f32x2 cs = ropet[pos * 32 + j + e]; o[e] = first ? acc[i][e] * cs.x - pacc[i][e] * cs.y : acc[i][e] * cs.x + pacc[i][e] * cs.y; }
      }
      *(u32x2*)(base + (size_t)row * ld + lc) = pk4(o);
    }
  }
}

__global__ void __launch_bounds__(256) k_n_memkv(Params p) {
  const bf16_t* memn = WSP(bf16_t, OFF_MEMN); bf16_t* kv = WSP(bf16_t, OFF_KV);
  const long items = (long)(1024 / 4) * 256;
  for (long it = (long)blockIdx.x * 256 + threadIdx.x; it < items; it += (long)gridDim.x * 256) {
    const int ng = (int)(it % 256), mg = (int)(it / 256), c = ng * 4;
    const bf16_t* a[4];
#pragma unroll
    for (int i = 0; i < 4; ++i) a[i] = memn + (size_t)(mg * 4 + i) * D;
    f32x4 acc[4] = {};
    const float* w = p.w_mem_kv + c;
    dot4x4(acc, a, D, [&](int k) { return *(const f32x4*)(w + (size_t)k * 1024); });
#pragma unroll
    for (int i = 0; i < 4; ++i) *(u32x2*)(kv + (size_t)(mg * 4 + i) * 1024 + c) = pk4(acc[i]);
  }
}

DEV unsigned f2key(float s) { const unsigned u = __float_as_uint(s); return (u & 0x80000000u) ? ~u : (u | 0x80000000u); }

__global__ void __launch_bounds__(256) k_n_topk(Params p) {
  __shared__ unsigned long long keys[8192];
  const bf16_t* iq = WSP(bf16_t, OFF_IQ); const bf16_t* ik = WSP(bf16_t, OFF_IK); const float* iw = WSP(float, OFF_IW);
  unsigned short* sel = WSP(unsigned short, OFF_SEL);
  for (int row = blockIdx.x; row < T; row += gridDim.x) {
    const int b = row / S, t = row % S, N = t + 1;
    int P2 = 256; while (P2 < N) P2 <<= 1;
    const float w0 = iw[row * 4 + 0], w1 = iw[row * 4 + 1], w2 = iw[row * 4 + 2], w3 = iw[row * 4 + 3];
    const bf16_t* q = iq + (size_t)row * 256;
    for (int j = threadIdx.x; j < P2; j += 256) {
      unsigned long long key = 0ull;
      if (j < N) {
        const bf16_t* kr = ik + (size_t)(b * S + j) * 64;
        float d0 = 0.f, d1 = 0.f, d2 = 0.f, d3 = 0.f;
        for (int c = 0; c < 64; c += 8) {
          const bf16x8 kk = *(const bf16x8*)(kr + c);
          const bf16x8 q0 = *(const bf16x8*)(q + c), q1 = *(const bf16x8*)(q + 64 + c), q2 = *(const bf16x8*)(q + 128 + c), q3 = *(const bf16x8*)(q + 192 + c);
#pragma unroll
          for (int e = 0; e < 8; ++e) { const float kf = bf2f((bf16_t)kk[e]); d0 += bf2f((bf16_t)q0[e]) * kf; d1 += bf2f((bf16_t)q1[e]) * kf; d2 += bf2f((bf16_t)q2[e]) * kf; d3 += bf2f((bf16_t)q3[e]) * kf; }
        }
        float sc = 0.f;
        sc = fmaf(w0, fmaxf(d0, 0.f), sc); sc = fmaf(w1, fmaxf(d1, 0.f), sc); sc = fmaf(w2, fmaxf(d2, 0.f), sc); sc = fmaf(w3, fmaxf(d3, 0.f), sc);
        sc += 0.0f;
        key = ((unsigned long long)f2key(sc) << 13) | (unsigned long long)(8191 - j);
      }
      keys[j] = key;
    }
    __syncthreads();
    if (N > 256) {
      for (int k = 2; k <= P2; k <<= 1)
        for (int j = k >> 1; j > 0; j >>= 1) {
          for (int i = threadIdx.x; i < P2; i += 256) {
            const int ixj = i ^ j;
            if (ixj > i) {
              const unsigned long long a = keys[i], c = keys[ixj];
              const bool desc = ((i & k) == 0);
              if (desc ? (a < c) : (a > c)) { keys[i] = c; keys[ixj] = a; }
            }
          }
          __syncthreads();
        }
    }
    {
      const int i = threadIdx.x;
      const unsigned long long kk = keys[i];
      sel[(size_t)row * 256 + i] = (i < N && i < 256) ? (unsigned short)(8191 - (int)(kk & 8191ull)) : (unsigned short)0;
    }
    __syncthreads();
  }
}

template <int DH, class KF>
DEV void naive_attn(const bf16_t* q, int nkeys, KF keyf, float scale, bf16_t* out) {
  const int lane = threadIdx.x & 63;
  constexpr int ND = DH / 64;
  float qv[ND], o[ND];
#pragma unroll
  for (int i = 0; i < ND; ++i) { qv[i] = bf2f(q[lane + 64 * i]); o[i] = 0.f; }
  float m = -INFINITY, l = 0.f;
  for (int kk = 0; kk < nkeys; ++kk) {
    const bf16_t *kr, *vr;
    if (!keyf(kk, kr, vr)) continue;
    float d = 0.f;
#pragma unroll
    for (int i = 0; i < ND; ++i) d += qv[i] * bf2f(kr[lane + 64 * i]);
    d = wave_sum(d) * scale;
    const float mn = fmaxf(m, d), f = __expf(m - mn), pe = __expf(d - mn);
    l = l * f + pe;
#pragma unroll
    for (int i = 0; i < ND; ++i) o[i] = o[i] * f + pe * bf2f(vr[lane + 64 * i]);
    m = mn;
  }
  const float inv = 1.0f / l;
#pragma unroll
  for (int i = 0; i < ND; ++i) out[lane + 64 * i] = f2bf(o[i] * inv);
}

__global__ void __launch_bounds__(256) k_n_attn_a(Params p) {
  const int gw = (blockIdx.x * 256 + threadIdx.x) >> 6, nw = (gridDim.x * 256) >> 6;
  bf16_t* aq = WSP(bf16_t, OFF_AQ); const bf16_t* ak = WSP(bf16_t, OFF_AK); const bf16_t* av = WSP(bf16_t, OFF_AV);
  const unsigned short* sel = WSP(unsigned short, OFF_SEL);
  for (int u = gw; u < T * 8; u += nw) {
    const int row = u >> 3, h = u & 7, kvh = h >> 2, b = row / S, t = row % S;
    const int cnt = t + 1 < 256 ? t + 1 : 256;
    bf16_t* q = aq + (size_t)row * 512 + h * 64;
    naive_attn<64>(q, cnt, [&](int kk, const bf16_t*& kr, const bf16_t*& vr) {
      const int j = sel[(size_t)row * 256 + kk]; const size_t r = (size_t)(b * S + j) * 128 + kvh * 64; kr = ak + r; vr = av + r; return true; }, 0.125f, q);
  }
}
__global__ void __launch_bounds__(256) k_n_attn_m(Params p) {
  const int gw = (blockIdx.x * 256 + threadIdx.x) >> 6, nw = (gridDim.x * 256) >> 6;
  bf16_t* mq = WSP(bf16_t, OFF_MQ); const bf16_t* kv = WSP(bf16_t, OFF_KV);
  for (int u = gw; u < T * 4; u += nw) {
    const int row = u >> 2, h = u & 3, b = row / S;
    bf16_t* q = mq + (size_t)row * 512 + h * 128;
    naive_attn<128>(q, 256, [&](int kk, const bf16_t*& kr, const bf16_t*& vr) {
      const size_t r = (size_t)(b * 256 + kk) * 1024 + h * 128; kr = kv + r; vr = kv + r + 512; return true; }, 0.08838834764831845f, q);
  }
}
__global__ void __launch_bounds__(256) k_n_attn_b(Params p) {
  const int gw = (blockIdx.x * 256 + threadIdx.x) >> 6, nw = (gridDim.x * 256) >> 6, lane = threadIdx.x & 63;
  const bf16_t* bq = WSP(bf16_t, OFF_BQ); const bf16_t* bk = WSP(bf16_t, OFF_BK); const bf16_t* bv = WSP(bf16_t, OFF_BV);
  bf16_t* yb = WSP(bf16_t, OFF_YB);
  for (int u = gw; u < T * 8; u += nw) {
    const int row = u >> 3, h = u & 7, t = row % S;
    float o = 0.f, m = -INFINITY, l = 0.f;
#pragma unroll
    for (int g = 0; g < 3; ++g) {
      const int dil = g == 0 ? 1 : (g == 1 ? 4 : 16);
      const float qv = bf2f(bq[(size_t)row * 1536 + (g * 8 + h) * 64 + lane]);
      for (int s = 0; s <= 128; ++s) {
        const int tk = t - s * dil; if (tk < 0) break;
        const size_t r = (size_t)(row - s * dil) * 1536 + (g * 8 + h) * 64 + lane;
        float d = wave_sum(qv * bf2f(bk[r])) * 0.125f;
        const float mn = fmaxf(m, d), f = __expf(m - mn), pe = __expf(d - mn);
        l = l * f + pe; o = o * f + pe * bf2f(bv[r]); m = mn;
      }
    }
    yb[(size_t)row * 512 + h * 64 + lane] = f2bf(o / l);
  }
}

__global__ void __launch_bounds__(256) k_n_gates(Params p) {
  const bf16_t* n = (const bf16_t*)p.out; bf16_t* gates = WSP(bf16_t, OFF_GATES);
  const int NG = 3072 / 4; const long items = (long)(T / 4) * NG;
  for (long it = (long)blockIdx.x * 256 + threadIdx.x; it < items; it += (long)gridDim.x * 256) {
    const int ng = (int)(it % NG), mg = (int)(it / NG), c = ng * 4;
    const bf16_t* a[4];
#pragma unroll
    for (int i = 0; i < 4; ++i) a[i] = n + (size_t)(mg * 4 + i) * D;
    f32x4 acc[4] = {};
    const float* w = p.w_gate + c;
    dot4x4(acc, a, D, [&](int k) { return *(const f32x4*)(w + (size_t)k * 3072); });
    const f32x4 bb = *(const f32x4*)(p.b_gate + c);
#pragma unroll
    for (int i = 0; i < 4; ++i) { f32x4 o; for (int e = 0; e < 4; ++e) o[e] = 1.0f / (1.0f + __expf(-(acc[i][e] + bb[e]))); *(u32x2*)(gates + (size_t)(mg * 4 + i) * 3072 + c) = pk4(o); }
  }
}
__global__ void __launch_bounds__(256) k_n_branch(Params p) {
  const bf16_t* gates = WSP(bf16_t, OFF_GATES); bf16_t* merged = WSP(bf16_t, OFF_MERGED);
  const bf16_t* ys[3] = {WSP(bf16_t, OFF_AQ), WSP(bf16_t, OFF_YB), WSP(bf16_t, OFF_MQ)};
  const int NG = 1024 / 4; const long items = (long)(T / 4) * NG;
  for (long it = (long)blockIdx.x * 256 + threadIdx.x; it < items; it += (long)gridDim.x * 256) {
    const int ng = (int)(it % NG), mg = (int)(it / NG), c = ng * 4;
    f32x4 tot[4] = {};
#pragma unroll
    for (int br = 0; br < 3; ++br) {
      const bf16_t* a[4];
#pragma unroll
      for (int i = 0; i < 4; ++i) a[i] = ys[br] + (size_t)(mg * 4 + i) * 512;
      f32x4 acc[4] = {};
      const float* w = p.w_branch + (size_t)br * 512 * 1024 + c;
      dot4x4(acc, a, 512, [&](int k) { return *(const f32x4*)(w + (size_t)k * 1024); });
#pragma unroll
      for (int i = 0; i < 4; ++i) { const f32x4 g = unpk4(*(const u32x2*)(gates + (size_t)(mg * 4 + i) * 3072 + br * 1024 + c)); tot[i] += g * acc[i]; }
    }
#pragma unroll
    for (int i = 0; i < 4; ++i) *(u32x2*)(merged + (size_t)(mg * 4 + i) * 1024 + c) = pk4(tot[i]);
  }
}
__global__ void __launch_bounds__(256) k_n_out(Params p) {
  const bf16_t* merged = WSP(bf16_t, OFF_MERGED);
  const int NG = 1024 / 4; const long items = (long)(T / 4) * NG;
  for (long it = (long)blockIdx.x * 256 + threadIdx.x; it < items; it += (long)gridDim.x * 256) {
    const int ng = (int)(it % NG), mg = (int)(it / NG), c = ng * 4;
    const bf16_t* a[4];
#pragma unroll
    for (int i = 0; i < 4; ++i) a[i] = merged + (size_t)(mg * 4 + i) * 1024;
    f32x4 acc[4] = {};
    const float* w = p.w_out + c;
    dot4x4(acc, a, D, [&](int k) { return *(const f32x4*)(w + (size_t)k * 1024); });
#pragma unroll
    for (int i = 0; i < 4; ++i) { const size_t o = (size_t)(mg * 4 + i) * 1024 + c; *(f32x4*)(p.out + o) = *(const f32x4*)(p.x + o) + acc[i]; }
  }
}

DEV void route_block(const Params& p, int blk, char* lds) {
  int* tok_e = (int*)lds;
  float* tok_w = (float*)(lds + 512);
  int* lcnt = (int*)(lds + 1024);
  int* gbase = (int*)(lds + 1088);
  int* rank = (int*)(lds + 1152);
  const int tid = threadIdx.x, lane = tid & 63, wid = tid >> 6;
  const float* h1 = p.out; bf16_t* hn = WSP(bf16_t, OFF_HN);
  if (tid < 16) lcnt[tid] = 0;
  for (int g4 = 0; g4 < 4; ++g4) {
    const int tok0 = blk * 64 + wid * 16 + g4 * 4;
    float acc[4][20]; float ss[4];
#pragma unroll
    for (int tk = 0; tk < 4; ++tk) { ss[tk] = 0.f;
#pragma unroll
      for (int j = 0; j < 20; ++j) acc[tk][j] = 0.f; }
    for (int i = 0; i < 16; ++i) {
      const int d = i * 64 + lane;
      float wg[20];
      { const f32x4 a = *(const f32x4*)(p.w_group + (size_t)d * 4); wg[0] = a[0]; wg[1] = a[1]; wg[2] = a[2]; wg[3] = a[3]; }
#pragma unroll
      for (int g = 0; g < 4; ++g) { const f32x4 a = *(const f32x4*)(p.w_sub + ((size_t)g * 1024 + d) * 4); wg[4 + 4 * g] = a[0]; wg[5 + 4 * g] = a[1]; wg[6 + 4 * g] = a[2]; wg[7 + 4 * g] = a[3]; }
      const float gf = p.g_ffn[d];
#pragma unroll
      for (int tk = 0; tk < 4; ++tk) {
        const float xv = h1[(size_t)(tok0 + tk) * D + d]; ss[tk] += xv * xv; const float xg = xv * gf;
#pragma unroll
        for (int j = 0; j < 20; ++j) acc[tk][j] = fmaf(xg, wg[j], acc[tk][j]);
      }
    }
    float rstd[4];
#pragma unroll
    for (int tk = 0; tk < 4; ++tk) { ss[tk] = wave_sum(ss[tk]); rstd[tk] = 1.0f / sqrtf(ss[tk] * (1.0f / D) + RMS_EPS);
#pragma unroll
      for (int j = 0; j < 20; ++j) acc[tk][j] = wave_sum(acc[tk][j]); }
#pragma unroll
    for (int tk = 0; tk < 4; ++tk)
      for (int i = 0; i < 16; ++i) { const int d = i * 64 + lane; hn[(size_t)(tok0 + tk) * D + d] = f2bf(h1[(size_t)(tok0 + tk) * D + d] * rstd[tk] * p.g_ffn[d]); }
#pragma unroll
    for (int tk = 0; tk < 4; ++tk) {
      float gl[4];
#pragma unroll
      for (int g = 0; g < 4; ++g) gl[g] = acc[tk][g] * rstd[tk] + p.b_group[g];
      int gs = 0; float gm = gl[0];
#pragma unroll
      for (int g = 1; g < 4; ++g) if (gl[g] > gm) { gm = gl[g]; gs = g; }
      float gden = 0.f;
#pragma unroll
      for (int g = 0; g < 4; ++g) gden += __expf(gl[g] - gm);
      const float gw = 1.0f / gden;
      float sl[4];
#pragma unroll
      for (int e = 0; e < 4; ++e) { float v = 0.f;
#pragma unroll
        for (int g = 0; g < 4; ++g) v = (gs == g) ? acc[tk][4 + 4 * g + e] * rstd[tk] + p.b_sub[g * 4 + e] : v;
        sl[e] = v; }
      int e0 = 0; float m0 = sl[0];
#pragma unroll
      for (int e = 1; e < 4; ++e) if (sl[e] > m0) { m0 = sl[e]; e0 = e; }
      int e1 = -1; float m1 = -INFINITY;
#pragma unroll
      for (int e = 0; e < 4; ++e) if (e != e0 && sl[e] > m1) { m1 = sl[e]; e1 = e; }
      const float p1 = __expf(m1 - m0);
      const float w0 = gw / (1.0f + p1), w1 = gw * p1 / (1.0f + p1);
      if (lane == 0) { const int tl = wid * 16 + g4 * 4 + tk; tok_e[tl * 2] = gs * 4 + e0; tok_e[tl * 2 + 1] = gs * 4 + e1; tok_w[tl * 2] = w0; tok_w[tl * 2 + 1] = w1; }
    }
  }
  __syncthreads();
  if (tid < 128) rank[tid] = atomicAdd(&lcnt[tok_e[tid]], 1);
  __syncthreads();
  if (tid < 16) gbase[tid] = (int)__hip_atomic_fetch_add(WSP(unsigned, OFF_CNT) + tid, (unsigned)lcnt[tid], __ATOMIC_RELAXED, __HIP_MEMORY_SCOPE_AGENT);
  __syncthreads();
  if (tid < 128) {
    const int e = tok_e[tid], ent = (blk * 64 + (tid >> 1)) * 2 + (tid & 1);
    WSP(int, OFF_LIST)[(size_t)e * T + gbase[e] + rank[tid]] = ent;
    WSP(float, OFF_CW)[ent] = tok_w[tid];
  }
  __syncthreads();
}
__global__ void __launch_bounds__(256) k_route(Params p) {
  __shared__ __attribute__((aligned(16))) char lds[2048];
  for (int blk = blockIdx.x; blk < T / 64; blk += gridDim.x) route_block(p, blk, lds);
}

__global__ void __launch_bounds__(256) k_n_up(Params p) {
  const bf16_t* hn = WSP(bf16_t, OFF_HN); bf16_t* hid = WSP(bf16_t, OFF_HID);
  const unsigned* cnt = WSP(unsigned, OFF_CNT); const int* list = WSP(int, OFF_LIST); const float* cw = WSP(float, OFF_CW);
  const int NG = 512 / 4;
  for (int e = 0; e < 16; ++e) {
    const int ne = (int)cnt[e], mgs = (ne + 3) / 4; const long items = (long)mgs * NG;
    for (long it = (long)blockIdx.x * 256 + threadIdx.x; it < items; it += (long)gridDim.x * 256) {
      const int ng = (int)(it % NG), mg = (int)(it / NG), c = ng * 4;
      const bf16_t* a[4]; int ent[4];
#pragma unroll
      for (int i = 0; i < 4; ++i) { const int r = mg * 4 + i; ent[i] = list[(size_t)e * T + (r < ne ? r : 0)]; a[i] = hn + (size_t)(ent[i] >> 1) * D; }
      f32x4 a1[4] = {}, a3[4] = {};
      const float* w1 = p.w1 + (size_t)e * 1024 * 512 + c; const float* w3 = p.w3 + (size_t)e * 1024 * 512 + c;
      dot4x4(a1, a, D, [&](int k) { return *(const f32x4*)(w1 + (size_t)k * 512); });
      dot4x4(a3, a, D, [&](int k) { return *(const f32x4*)(w3 + (size_t)k * 512); });
#pragma unroll
      for (int i = 0; i < 4; ++i) if (mg * 4 + i < ne) {
        const float cwv = cw[ent[i]]; f32x4 o;
        for (int q = 0; q < 4; ++q) { const float v = a1[i][q]; o[q] = v / (1.0f + __expf(-v)) * a3[i][q] * cwv; }
        *(u32x2*)(hid + (size_t)ent[i] * 512 + c) = pk4(o);
      }
    }
  }
}
__global__ void __launch_bounds__(256) k_n_down(Params p) {
  const bf16_t* hid = WSP(bf16_t, OFF_HID); bf16_t* moe = WSP(bf16_t, OFF_MOE);
  const unsigned* cnt = WSP(unsigned, OFF_CNT); const int* list = WSP(int, OFF_LIST);
  const int NG = 1024 / 4;
  for (int e = 0; e < 16; ++e) {
    const int ne = (int)cnt[e], mgs = (ne + 3) / 4; const long items = (long)mgs * NG;
    for (long it = (long)blockIdx.x * 256 + threadIdx.x; it < items; it += (long)gridDim.x * 256) {
      const int ng = (int)(it % NG), mg = (int)(it / NG), c = ng * 4;
      const bf16_t* a[4]; int ent[4];
#pragma unroll
      for (int i = 0; i < 4; ++i) { const int r = mg * 4 + i; ent[i] = list[(size_t)e * T + (r < ne ? r : 0)]; a[i] = hid + (size_t)ent[i] * 512; }
      f32x4 acc[4] = {};
      const float* w = p.w2 + (size_t)e * 512 * 1024 + c;
      dot4x4(acc, a, 512, [&](int k) { return *(const f32x4*)(w + (size_t)k * 1024); });
#pragma unroll
      for (int i = 0; i < 4; ++i) if (mg * 4 + i < ne) *(u32x2*)(moe + (size_t)ent[i] * 1024 + c) = pk4(acc[i]);
    }
  }
}

__global__ void __launch_bounds__(256) k_final(Params p) {
  const int lane = threadIdx.x & 63, gw = (blockIdx.x * 256 + threadIdx.x) >> 6, nw = (gridDim.x * 256) >> 6;
  const bf16_t* moe = WSP(bf16_t, OFF_MOE);
  for (int r = gw; r < T; r += nw) {
    f32x4 v[4]; float ss = 0.f;
#pragma unroll
    for (int i = 0; i < 4; ++i) {
      const int c = i * 256 + lane * 4;
      v[i] = *(const f32x4*)(p.out + (size_t)r * D + c) + unpk4(*(const u32x2*)(moe + (size_t)(2 * r) * D + c)) + unpk4(*(const u32x2*)(moe + (size_t)(2 * r + 1) * D + c));
      ss += v[i][0] * v[i][0] + v[i][1] * v[i][1] + v[i][2] * v[i][2] + v[i][3] * v[i][3];
    }
    ss = wave_sum(ss);
    const float rstd = 1.0f / sqrtf(ss * (1.0f / D) + RMS_EPS);
#pragma unroll
    for (int i = 0; i < 4; ++i) { const int c = i * 256 + lane * 4; *(f32x4*)(p.out + (size_t)r * D + c) = v[i] * rstd * *(const f32x4*)(p.g_final + c); }
  }
}


constexpr int LDS_BYTES = 66560;
constexpr int NIN_PAD = 6272;

template <class SF> DEV void transpose_tile(bf16_t* dst, int ldd, int n0, int k0, SF src, float* tile) {
  const int t = threadIdx.x;
#pragma unroll
  for (int i = 0; i < 16; ++i) { const int kk = (t >> 6) + 4 * i; tile[kk * 65 + (t & 63)] = src(k0 + kk, n0 + (t & 63)); }
  __syncthreads();
  const int n = t >> 2, kc = (t & 3) * 16;
  float v[16];
#pragma unroll
  for (int j = 0; j < 16; ++j) v[j] = tile[(kc + j) * 65 + n];
  u32x4 o0, o1;
  o0.x = pk2(v[0], v[1]); o0.y = pk2(v[2], v[3]); o0.z = pk2(v[4], v[5]); o0.w = pk2(v[6], v[7]);
  o1.x = pk2(v[8], v[9]); o1.y = pk2(v[10], v[11]); o1.z = pk2(v[12], v[13]); o1.w = pk2(v[14], v[15]);
  bf16_t* d = dst + (size_t)(n0 + n) * ldd + k0 + kc;
  *(u32x4*)d = o0; *(u32x4*)(d + 8) = o1;
  __syncthreads();
}
DEV void ph_transposes(const Params& p, char* lds) {
  float* tile = (float*)lds;
  constexpr int J0 = 98 * 16, J1 = J0 + 48 * 16, J2 = J1 + 3 * 16 * 8, J3 = J2 + 256, J4 = J3 + 256, J5 = J4 + 16 * 256, J6 = J5 + 16 * 128;
  for (int job = blockIdx.x; job < J6; job += gridDim.x) {
    if (job < J0) { const int nt = job / 16, kt = job % 16; const float* w = p.w_in;
      transpose_tile(WSP(bf16_t, OFF_WIN), 1024, nt * 64, kt * 64, [&](int k, int n) { return n < C_END ? w[(size_t)k * INW + src_col(n)] : 0.f; }, tile); }
    else if (job < J1) { const int j = job - J0, nt = j / 16, kt = j % 16; const float* w = p.w_gate;
      transpose_tile(WSP(bf16_t, OFF_WG), 1024, nt * 64, kt * 64, [&](int k, int n) { return w[(size_t)k * 3072 + n]; }, tile); }
    else if (job < J2) { const int j = job - J1, br = j / 128, r = j % 128, nt = r / 8, kt = r % 8; const float* w = p.w_branch + (size_t)br * 512 * 1024;
      transpose_tile(WSP(bf16_t, OFF_WB) + (size_t)br * 1024 * 512, 512, nt * 64, kt * 64, [&](int k, int n) { return w[(size_t)k * 1024 + n]; }, tile); }
    else if (job < J3) { const int j = job - J2, nt = j / 16, kt = j % 16; const float* w = p.w_out;
      transpose_tile(WSP(bf16_t, OFF_WO), 1024, nt * 64, kt * 64, [&](int k, int n) { return w[(size_t)k * 1024 + n]; }, tile); }
    else if (job < J4) { const int j = job - J3, nt = j / 16, kt = j % 16; const float* w = p.w_mem_kv;
      transpose_tile(WSP(bf16_t, OFF_WM), 1024, nt * 64, kt * 64, [&](int k, int n) { return w[(size_t)k * 1024 + n]; }, tile); }
    else if (job < J5) { const int j = job - J4, e = j / 256, r = j % 256, nt = r / 16, kt = r % 16;
      const float* w1 = p.w1 + (size_t)e * 1024 * 512; const float* w3 = p.w3 + (size_t)e * 1024 * 512;
      transpose_tile(WSP(bf16_t, OFF_W13) + (size_t)e * 1024 * 1024, 1024, nt * 64, kt * 64, [&](int k, int jj) {
        const int hid = (jj >> 7) * 64 + ((jj >> 6) & 1) * 32 + (jj & 31); return ((jj >> 5) & 1) ? w3[(size_t)k * 512 + hid] : w1[(size_t)k * 512 + hid]; }, tile); }
    else { const int j = job - J5, e = j / 128, r = j % 128, nt = r / 8, kt = r % 8; const float* w = p.w2 + (size_t)e * 512 * 1024;
      transpose_tile(WSP(bf16_t, OFF_W2) + (size_t)e * 1024 * 512, 512, nt * 64, kt * 64, [&](int k, int n) { return w[(size_t)k * 1024 + n]; }, tile); }
  }
}

template <class AR>
DEV void gemm_kloop(f32x4 (&acc)[4][4], AR arow, const bf16_t* __restrict__ Bt, int ldb, int K, char* lds) {
  const int tid = threadIdx.x, lane = tid & 63, wid = tid >> 6, wr = wid >> 1, wc = wid & 1, fr = lane & 15, fq = lane >> 4;
  const int lrow = tid >> 3, lch = tid & 7;
  const bf16_t* ap[4]; const bf16_t* bp[4];
#pragma unroll
  for (int i = 0; i < 4; ++i) { ap[i] = arow(lrow + 32 * i) + lch * 8; bp[i] = Bt + (size_t)(lrow + 32 * i) * ldb + lch * 8; }
  const int wofs = lrow * 128 + (((lch ^ (lrow >> 1)) & 7) << 4);
  const int rofs = fr * 128 + (((fq ^ (fr >> 1)) & 7) << 4);
  u32x4 ra[4], rb[4];
#pragma unroll
  for (int i = 0; i < 4; ++i) { ra[i] = *(const u32x4*)ap[i]; rb[i] = *(const u32x4*)bp[i]; }
#pragma unroll
  for (int i = 0; i < 4; ++i) { *(u32x4*)(lds + wofs + i * 4096) = ra[i]; *(u32x4*)(lds + 16384 + wofs + i * 4096) = rb[i]; }
  __syncthreads();
  const int nk = K >> 6;
  for (int kt = 0; kt < nk; ++kt) {
    const char* cur = lds + (kt & 1) * 32768;
    const bool more = kt + 1 < nk;
    if (more) {
#pragma unroll
      for (int i = 0; i < 4; ++i) { ra[i] = *(const u32x4*)(ap[i] + (kt + 1) * 64); rb[i] = *(const u32x4*)(bp[i] + (kt + 1) * 64); }
    }
#pragma unroll
    for (int kk = 0; kk < 2; ++kk) {
      bf16x8 af[4], bfr[4];
      const char* ab = cur + wr * 8192 + (rofs ^ (kk << 6));
      const char* bb = cur + 16384 + wc * 8192 + (rofs ^ (kk << 6));
#pragma unroll
      for (int m = 0; m < 4; ++m) { af[m] = *(const bf16x8*)(ab + m * 2048); bfr[m] = *(const bf16x8*)(bb + m * 2048); }
#pragma unroll
      for (int m = 0; m < 4; ++m)
#pragma unroll
        for (int n = 0; n < 4; ++n) acc[m][n] = __builtin_amdgcn_mfma_f32_16x16x32_bf16(bfr[n], af[m], acc[m][n], 0, 0, 0);
    }
    if (more) {
      char* nxt = lds + ((kt + 1) & 1) * 32768;
#pragma unroll
      for (int i = 0; i < 4; ++i) { *(u32x4*)(nxt + wofs + i * 4096) = ra[i]; *(u32x4*)(nxt + 16384 + wofs + i * 4096) = rb[i]; }
    }
    __syncthreads();
  }
}
#define ZERO_ACC(a) _Pragma("unroll") for (int m_ = 0; m_ < 4; ++m_) _Pragma("unroll") for (int n_ = 0; n_ < 4; ++n_) a[m_][n_] = (f32x4){0.f, 0.f, 0.f, 0.f}

DEV void ph_gemm1(const Params& p, char* lds) {
  const bf16_t* nrm = (const bf16_t*)p.out; const bf16_t* WinT = WSP(bf16_t, OFF_WIN);
  const f32x2* ropet = WSP(f32x2, OFF_ROPE);
  const int lane = threadIdx.x & 63, wid = threadIdx.x >> 6, wr = wid >> 1, wc = wid & 1, fr = lane & 15, fq = lane >> 4;
  constexpr int NT = NIN_PAD / 128, MT = T / 128;
  for (int tile = blockIdx.x; tile < MT * NT + 64; tile += gridDim.x) {
    f32x4 acc[4][4]; ZERO_ACC(acc);
    if (tile < MT * NT) {
      const int pm = tile / NT, pn = tile % NT;
      const bf16_t* A = nrm + (size_t)pm * 128 * D;
      gemm_kloop(acc, [&](int r) { return A + (size_t)r * D; }, WinT + (size_t)pn * 128 * D, D, D, lds);
      const int c0 = pn * 128 + wc * 64;
      if (c0 < C_IW) {
        bf16_t* base; int ld, lc; bool rope; g1_dest(p, c0, base, ld, lc, rope);
#pragma unroll
        for (int m = 0; m < 4; ++m) {
          const int row = pm * 128 + wr * 64 + m * 16 + fr;
          if (rope) {
            const int pos = row & (S - 1);
#pragma unroll
            for (int n = 0; n < 2; ++n) {
              const f32x4 t0 = *(const f32x4*)(ropet + pos * 32 + n * 16 + 4 * fq), t1 = *(const f32x4*)(ropet + pos * 32 + n * 16 + 4 * fq + 2);
              const float cs[4] = {t0[0], t0[2], t1[0], t1[2]}, sn[4] = {t0[1], t0[3], t1[1], t1[3]};
              const f32x4 lo = acc[m][n], hi = acc[m][n + 2];
#pragma unroll
              for (int e = 0; e < 4; ++e) { acc[m][n][e] = lo[e] * cs[e] - hi[e] * sn[e]; acc[m][n + 2][e] = hi[e] * cs[e] + lo[e] * sn[e]; }
            }
          }
#pragma unroll
          for (int n = 0; n < 4; ++n) *(u32x2*)(base + (size_t)row * ld + lc + n * 16 + 4 * fq) = pk4(acc[m][n]);
        }
      } else if (c0 == C_IW) {
        if (fq == 0) {
#pragma unroll
          for (int m = 0; m < 4; ++m) { const int row = pm * 128 + wr * 64 + m * 16 + fr; *(f32x4*)(WSP(float, OFF_IW) + (size_t)row * 4) = acc[m][0]; }
        }
      }
    } else {
      const int t2 = tile - MT * NT, pm = t2 >> 3, pn = t2 & 7;
      const bf16_t* A = WSP(bf16_t, OFF_MEMN) + (size_t)pm * 128 * D;
      gemm_kloop(acc, [&](int r) { return A + (size_t)r * D; }, WSP(bf16_t, OFF_WM) + (size_t)pn * 128 * D, D, D, lds);
      bf16_t* kv = WSP(bf16_t, OFF_KV);
#pragma unroll
      for (int m = 0; m < 4; ++m) { const int row = pm * 128 + wr * 64 + m * 16 + fr;
#pragma unroll
        for (int n = 0; n < 4; ++n) *(u32x2*)(kv + (size_t)row * 1024 + pn * 128 + wc * 64 + n * 16 + 4 * fq) = pk4(acc[m][n]); }
    }
  }
}


DEV void ph_gates(const Params& p, char* lds) {
  const bf16_t* nrm = (const bf16_t*)p.out; const bf16_t* WgT = WSP(bf16_t, OFF_WG); bf16_t* gates = WSP(bf16_t, OFF_GATES);
  const int lane = threadIdx.x & 63, wid = threadIdx.x >> 6, wr = wid >> 1, wc = wid & 1, fr = lane & 15, fq = lane >> 4;
  constexpr int NT = 3072 / 128, MT = T / 128;
  for (int tile = blockIdx.x; tile < MT * NT; tile += gridDim.x) {
    const int pm = tile / NT, pn = tile % NT;
    f32x4 acc[4][4]; ZERO_ACC(acc);
    const bf16_t* A = nrm + (size_t)pm * 128 * D;
    gemm_kloop(acc, [&](int r) { return A + (size_t)r * D; }, WgT + (size_t)pn * 128 * D, D, D, lds);
#pragma unroll
    for (int n = 0; n < 4; ++n) {
      const int col = pn * 128 + wc * 64 + n * 16 + 4 * fq;
      const f32x4 bb = *(const f32x4*)(p.b_gate + col);
#pragma unroll
      for (int m = 0; m < 4; ++m) {
        const int row = pm * 128 + wr * 64 + m * 16 + fr; f32x4 o;
#pragma unroll
        for (int e = 0; e < 4; ++e) o[e] = 1.0f / (1.0f + __expf(-(acc[m][n][e] + bb[e])));
        *(u32x2*)(gates + (size_t)row * 3072 + col) = pk4(o);
      }
    }
  }
}
DEV void ph_branch(const Params& p, char* lds) {
  const bf16_t* gates = WSP(bf16_t, OFF_GATES); bf16_t* merged = WSP(bf16_t, OFF_MERGED); const bf16_t* WbT = WSP(bf16_t, OFF_WB);
  const int lane = threadIdx.x & 63, wid = threadIdx.x >> 6, wr = wid >> 1, wc = wid & 1, fr = lane & 15, fq = lane >> 4;
  constexpr int NT = 1024 / 128, MT = T / 128;
  for (int tile = blockIdx.x; tile < MT * NT; tile += gridDim.x) {
    const int pm = tile / NT, pn = tile % NT;
    f32x4 tot[4][4]; ZERO_ACC(tot);
#pragma unroll 1
    for (int br = 0; br < 3; ++br) {
      const bf16_t* A = (br == 0 ? WSP(bf16_t, OFF_AQ) : (br == 1 ? WSP(bf16_t, OFF_YB) : WSP(bf16_t, OFF_MQ))) + (size_t)pm * 128 * 512;
      f32x4 acc[4][4]; ZERO_ACC(acc);
      gemm_kloop(acc, [&](int r) { return A + (size_t)r * 512; }, WbT + ((size_t)br * 1024 + pn * 128) * 512, 512, 512, lds);
#pragma unroll
      for (int m = 0; m < 4; ++m) { const int row = pm * 128 + wr * 64 + m * 16 + fr;
#pragma unroll
        for (int n = 0; n < 4; ++n) { const f32x4 g = unpk4(*(const u32x2*)(gates + (size_t)row * 3072 + br * 1024 + pn * 128 + wc * 64 + n * 16 + 4 * fq)); tot[m][n] += g * acc[m][n]; } }
    }
#pragma unroll
    for (int m = 0; m < 4; ++m) { const int row = pm * 128 + wr * 64 + m * 16 + fr;
#pragma unroll
      for (int n = 0; n < 4; ++n) *(u32x2*)(merged + (size_t)row * 1024 + pn * 128 + wc * 64 + n * 16 + 4 * fq) = pk4(tot[m][n]); }
  }
}
DEV void ph_out(const Params& p, char* lds) {
  const bf16_t* merged = WSP(bf16_t, OFF_MERGED); const bf16_t* WoT = WSP(bf16_t, OFF_WO);
  const int lane = threadIdx.x & 63, wid = threadIdx.x >> 6, wr = wid >> 1, wc = wid & 1, fr = lane & 15, fq = lane >> 4;
  constexpr int NT = 1024 / 128, MT = T / 128;
  for (int tile = blockIdx.x; tile < MT * NT; tile += gridDim.x) {
    const int pm = tile / NT, pn = tile % NT;
    f32x4 acc[4][4]; ZERO_ACC(acc);
    const bf16_t* A = merged + (size_t)pm * 128 * 1024;
    gemm_kloop(acc, [&](int r) { return A + (size_t)r * 1024; }, WoT + (size_t)pn * 128 * 1024, 1024, 1024, lds);
#pragma unroll
    for (int m = 0; m < 4; ++m) { const int row = pm * 128 + wr * 64 + m * 16 + fr;
#pragma unroll
      for (int n = 0; n < 4; ++n) { const size_t o = (size_t)row * 1024 + pn * 128 + wc * 64 + n * 16 + 4 * fq; *(f32x4*)(p.out + o) = *(const f32x4*)(p.x + o) + acc[m][n]; } }
  }
}
DEV bool moe_tile(const unsigned* cnt, int tile, int& e, int& mt, int& nt, int& ne) {
  int rt = tile >> 3; nt = tile & 7;
  for (e = 0; e < 16; ++e) { ne = (int)cnt[e]; const int te = (ne + 127) >> 7; if (rt < te) { mt = rt; return true; } rt -= te; }
  return false;
}
DEV void ph_up(const Params& p, char* lds) {
  const bf16_t* hn = WSP(bf16_t, OFF_HN); bf16_t* hid = WSP(bf16_t, OFF_HID); const bf16_t* W13T = WSP(bf16_t, OFF_W13);
  const unsigned* cnt = WSP(unsigned, OFF_CNT); const int* list = WSP(int, OFF_LIST); const float* cw = WSP(float, OFF_CW);
  const int lane = threadIdx.x & 63, wid = threadIdx.x >> 6, wr = wid >> 1, wc = wid & 1, fr = lane & 15, fq = lane >> 4;
  for (int tile = blockIdx.x;; tile += gridDim.x) {
    int e, mt, nt, ne; if (!moe_tile(cnt, tile, e, mt, nt, ne)) break;
    const int* le = list + (size_t)e * T;
    f32x4 acc[4][4]; ZERO_ACC(acc);
    gemm_kloop(acc, [&](int r) { const int rr = mt * 128 + r; return hn + (size_t)(le[rr < ne ? rr : ne - 1] >> 1) * D; }, W13T + ((size_t)e * 1024 + nt * 128) * 1024, 1024, 1024, lds);
#pragma unroll
    for (int m = 0; m < 4; ++m) {
      const int rr = mt * 128 + wr * 64 + m * 16 + fr;
      if (rr < ne) {
        const int ent = le[rr]; const float cwv = cw[ent];
#pragma unroll
        for (int n = 0; n < 2; ++n) { f32x4 o;
#pragma unroll
          for (int q = 0; q < 4; ++q) { const float v = acc[m][n][q]; o[q] = v / (1.0f + __expf(-v)) * acc[m][n + 2][q] * cwv; }
          *(u32x2*)(hid + (size_t)ent * 512 + nt * 64 + wc * 32 + n * 16 + 4 * fq) = pk4(o); }
      }
    }
  }
}
DEV void ph_down(const Params& p, char* lds) {
  const bf16_t* hid = WSP(bf16_t, OFF_HID); bf16_t* moe = WSP(bf16_t, OFF_MOE); const bf16_t* W2T = WSP(bf16_t, OFF_W2);
  const unsigned* cnt = WSP(unsigned, OFF_CNT); const int* list = WSP(int, OFF_LIST);
  const int lane = threadIdx.x & 63, wid = threadIdx.x >> 6, wr = wid >> 1, wc = wid & 1, fr = lane & 15, fq = lane >> 4;
  for (int tile = blockIdx.x;; tile += gridDim.x) {
    int e, mt, nt, ne; if (!moe_tile(cnt, tile, e, mt, nt, ne)) break;
    const int* le = list + (size_t)e * T;
    f32x4 acc[4][4]; ZERO_ACC(acc);
    gemm_kloop(acc, [&](int r) { const int rr = mt * 128 + r; return hid + (size_t)le[rr < ne ? rr : ne - 1] * 512; }, W2T + ((size_t)e * 1024 + nt * 128) * 512, 512, 512, lds);
#pragma unroll
    for (int m = 0; m < 4; ++m) {
      const int rr = mt * 128 + wr * 64 + m * 16 + fr;
      if (rr < ne) { const int ent = le[rr];
#pragma unroll
        for (int n = 0; n < 4; ++n) *(u32x2*)(moe + (size_t)ent * 1024 + nt * 128 + wc * 64 + n * 16 + 4 * fq) = pk4(acc[m][n]); }
    }
  }
}

typedef short v4i16_t __attribute__((ext_vector_type(4)));
template <int DH, int NKB, class KR, class VR, class MK>
DEV void attend16(const bf16_t* qrow, KR krow, VR vrow, MK mask, float sl2, char* vl, f32x4 (&o)[DH / 16], float& lse2) {
  const int lane = threadIdx.x & 63, fr = lane & 15, fq = lane >> 4;
  constexpr int KS = DH / 32, STRIDE = DH * 2 + 32, ND = DH / 16;
  bf16x8 qf[KS];
#pragma unroll
  for (int s = 0; s < KS; ++s) qf[s] = *(const bf16x8*)(qrow + 32 * s + 8 * fq);
  f32x4 sc[NKB];
#pragma unroll
  for (int kb = 0; kb < NKB; ++kb) {
    const bf16_t* kr = krow(kb * 16 + fr);
    f32x4 a = {0.f, 0.f, 0.f, 0.f};
#pragma unroll
    for (int s = 0; s < KS; ++s) { const bf16x8 kf = *(const bf16x8*)(kr + 32 * s + 8 * fq); a = __builtin_amdgcn_mfma_f32_16x16x32_bf16(kf, qf[s], a, 0, 0, 0); }
    sc[kb] = a;
  }
  float mx = -INFINITY;
#pragma unroll
  for (int kb = 0; kb < NKB; ++kb)
#pragma unroll
    for (int i = 0; i < 4; ++i) { float v = sc[kb][i] * sl2; v = mask(kb * 16 + 4 * fq + i, fr) ? v : -INFINITY; sc[kb][i] = v; mx = fmaxf(mx, v); }
  mx = fmaxf(mx, __shfl_xor(mx, 16)); mx = fmaxf(mx, __shfl_xor(mx, 32));
  float l = 0.f;
#pragma unroll
  for (int kb = 0; kb < NKB; ++kb)
#pragma unroll
    for (int i = 0; i < 4; ++i) { const float pe = __builtin_amdgcn_exp2f(sc[kb][i] - mx); sc[kb][i] = pe; l += pe; }
  l += __shfl_xor(l, 16); l += __shfl_xor(l, 32);
#pragma unroll
  for (int db = 0; db < ND; ++db) o[db] = (f32x4){0.f, 0.f, 0.f, 0.f};
  typedef __attribute__((address_space(3))) v4i16_t* lds_v4p;
  const lds_v4p trb = (lds_v4p)(vl + (4 * fq + (fr >> 2)) * STRIDE + (fr & 3) * 8);
  char* wp = vl + (lane >> 1) * STRIDE + (lane & 1) * DH;
#pragma unroll
  for (int pb = 0; pb < NKB / 2; ++pb) {
    const bf16_t* vr = vrow(pb * 32 + (lane >> 1)) + (lane & 1) * (DH / 2);
    u32x4 tmp[ND];
#pragma unroll
    for (int j = 0; j < ND; ++j) tmp[j] = *(const u32x4*)(vr + 8 * j);
#pragma unroll
    for (int j = 0; j < ND; ++j) *(u32x4*)(wp + 16 * j) = tmp[j];
    u32x4 pw; pw.x = pk2(sc[2 * pb][0], sc[2 * pb][1]); pw.y = pk2(sc[2 * pb][2], sc[2 * pb][3]); pw.z = pk2(sc[2 * pb + 1][0], sc[2 * pb + 1][1]); pw.w = pk2(sc[2 * pb + 1][2], sc[2 * pb + 1][3]);
    const bf16x8 pf = __builtin_bit_cast(bf16x8, pw);
#pragma unroll
    for (int db = 0; db < ND; ++db) {
      const v4i16_t lo = __builtin_amdgcn_ds_read_tr16_b64_v4i16((lds_v4p)((__attribute__((address_space(3))) char*)trb + db * 32));
      const v4i16_t hi = __builtin_amdgcn_ds_read_tr16_b64_v4i16((lds_v4p)((__attribute__((address_space(3))) char*)trb + db * 32 + 16 * STRIDE));
      const bf16x8 vf = {lo[0], lo[1], lo[2], lo[3], hi[0], hi[1], hi[2], hi[3]};
      o[db] = __builtin_amdgcn_mfma_f32_16x16x32_bf16(vf, pf, o[db], 0, 0, 0);
    }
  }
  const float inv = 1.0f / l;
#pragma unroll
  for (int db = 0; db < ND; ++db) o[db] *= inv;
  lse2 = mx + __builtin_amdgcn_logf(l);
}

constexpr float LOG2E = 1.4426950408889634f;
DEV void unit_attn_m(const Params& p, int u, char* vl) {
  const int lane = threadIdx.x & 63, fr = lane & 15, fq = lane >> 4;
  const int tile = u >> 2, h = u & 3, t0 = tile * 16, b = t0 / S;
  bf16_t* q = WSP(bf16_t, OFF_MQ) + (size_t)(t0 + fr) * 512 + h * 128;
  const bf16_t* kvb = WSP(bf16_t, OFF_KV) + (size_t)b * 256 * 1024 + h * 128;
  f32x4 o[8]; float lse;
  attend16<128, 16>(q, [&](int k) { return kvb + (size_t)k * 1024; }, [&](int k) { return kvb + (size_t)k * 1024 + 512; }, [&](int, int) { return true; },
                    0.08838834764831845f * LOG2E, vl, o, lse);
#pragma unroll
  for (int db = 0; db < 8; ++db) *(u32x2*)(q + 16 * db + 4 * fq) = pk4(o[db]);
}
DEV void unit_attn_b(const Params& p, int u, char* vl) {
  const int lane = threadIdx.x & 63, fr = lane & 15, fq = lane >> 4;
  const int x = u & 511, bgh = u >> 9, h = bgh & 7, bg = bgh >> 3, g = bg % 3, b = bg / 3;
  const int dsh = 2 * g, dil = 1 << dsh;
  const int tps = (S >> dsh) >> 4;
  const int res = x / tps, u0 = (x % tps) * 16;
  const size_t hoff = (size_t)(g * 8 + h) * 64;
  const int tq = ((u0 + fr) << dsh) + res;
  bf16_t* q = WSP(bf16_t, OFF_BQ) + (size_t)(b * S + tq) * 1536 + hoff;
  const bf16_t* kb_ = WSP(bf16_t, OFF_BK) + (size_t)b * S * 1536 + hoff;
  const bf16_t* vb_ = WSP(bf16_t, OFF_BV) + (size_t)b * S * 1536 + hoff;
  f32x4 o[4]; float lse;
  attend16<64, 10>(q,
    [&](int k) { int us = u0 - 144 + k; us = us < 0 ? 0 : us; return kb_ + (size_t)((us << dsh) + res) * 1536; },
    [&](int k) { int us = u0 - 144 + k; us = us < 0 ? 0 : us; return vb_ + (size_t)((us << dsh) + res) * 1536; },
    [&](int k, int c) { const int us = u0 - 144 + k, uq = u0 + c; return us >= 0 && us <= uq && us >= uq - 128; },
    0.125f * LOG2E, vl, o, lse);
#pragma unroll
  for (int db = 0; db < 4; ++db) *(u32x2*)(q + 16 * db + 4 * fq) = pk4(o[db]);
  if (fq == 0) WSP(float, OFF_LSE)[(size_t)(b * S + tq) * 24 + g * 8 + h] = lse;
}
DEV void unit_attn_a(const Params& p, int u, char* vl) {
  const int lane = threadIdx.x & 63, fr = lane & 15, fq = lane >> 4;
  const int row = u >> 1, kvh = u & 1, b = row / S, t = row % S;
  const int cnt = t + 1 < 256 ? t + 1 : 256;
  bf16_t* q = WSP(bf16_t, OFF_AQ) + (size_t)row * 512 + (kvh * 4 + (fr & 3)) * 64;
  const unsigned short* sl = WSP(unsigned short, OFF_SEL) + (size_t)row * 256;
  const bf16_t* kb_ = WSP(bf16_t, OFF_AK) + (size_t)b * S * 128 + kvh * 64;
  const bf16_t* vb_ = WSP(bf16_t, OFF_AV) + (size_t)b * S * 128 + kvh * 64;
  f32x4 o[4]; float lse;
  attend16<64, 16>(q,
    [&](int k) { const int j = k < cnt ? (int)sl[k] : 0; return kb_ + (size_t)j * 128; },
    [&](int k) { const int j = k < cnt ? (int)sl[k] : 0; return vb_ + (size_t)j * 128; },
    [&](int k, int) { return k < cnt; }, 0.125f * LOG2E, vl, o, lse);
  if (fr < 4) {
#pragma unroll
    for (int db = 0; db < 4; ++db) *(u32x2*)(q + 16 * db + 4 * fq) = pk4(o[db]);
  }
}
DEV void ph_attn_units(const Params& p, char* lds, bool doA) {
  const int wid = threadIdx.x >> 6;
  char* vl = lds + wid * 9216;
  const int gw = blockIdx.x * 4 + wid, nw = gridDim.x * 4;
  constexpr int NM = (T / 16) * 4, NBU = NB * 3 * 8 * 512, NA = T * 2;
  for (int u = gw; u < NM; u += nw) unit_attn_m(p, u, vl);
  for (int u = gw; u < NBU; u += nw) unit_attn_b(p, u, vl);
  if (doA) for (int u = gw; u < NA; u += nw) unit_attn_a(p, u, vl);
}
DEV void ph_mergeb(const Params& p) {
  const bf16_t* og = WSP(bf16_t, OFF_BQ); const float* lse = WSP(float, OFF_LSE); bf16_t* yb = WSP(bf16_t, OFF_YB);
  for (int it = blockIdx.x * 256 + threadIdx.x; it < T * 64; it += gridDim.x * 256) {
    const int ch = it & 7, h = (it >> 3) & 7, row = it >> 6;
    const float l0 = lse[(size_t)row * 24 + h], l1 = lse[(size_t)row * 24 + 8 + h], l2 = lse[(size_t)row * 24 + 16 + h];
    const float mx = fmaxf(l0, fmaxf(l1, l2));
    float a0 = __builtin_amdgcn_exp2f(l0 - mx), a1 = __builtin_amdgcn_exp2f(l1 - mx), a2 = __builtin_amdgcn_exp2f(l2 - mx);
    const float inv = 1.0f / (a0 + a1 + a2); a0 *= inv; a1 *= inv; a2 *= inv;
    const bf16_t* src = og + (size_t)row * 1536 + h * 64 + ch * 8;
    const u32x4 v0 = *(const u32x4*)src, v1 = *(const u32x4*)(src + 512), v2 = *(const u32x4*)(src + 1024);
    u32x4 r;
#pragma unroll
    for (int e = 0; e < 4; ++e) {
      const float lo = a0 * __uint_as_float(v0[e] << 16) + a1 * __uint_as_float(v1[e] << 16) + a2 * __uint_as_float(v2[e] << 16);
      const float hi = a0 * __uint_as_float(v0[e] & 0xFFFF0000u) + a1 * __uint_as_float(v1[e] & 0xFFFF0000u) + a2 * __uint_as_float(v2[e] & 0xFFFF0000u);
      r[e] = pk2(lo, hi);
    }
    *(u32x4*)(yb + (size_t)row * 512 + h * 64 + ch * 8) = r;
  }
}
__global__ void __launch_bounds__(256, 2) k_f_attn(Params p) { extern __shared__ __attribute__((aligned(16))) char lds[]; ph_attn_units(p, lds, true); }
__global__ void __launch_bounds__(256, 2) k_f_mergeb(Params p) { ph_mergeb(p); }

template <int PASS>
DEV void topk_pass(const bf16_t* ikb, unsigned short* selb, int t0, int qt, const bf16x8 (&af)[8][2], const f32x4 (&wv)[8], unsigned* hist, int* st,
                   const int (&ra)[8], const int (&rb_)[8]) {
  const int lane = threadIdx.x & 63, wid = threadIdx.x >> 6, kx = lane & 15, q4 = lane >> 4;
  const int nslab = 2 * qt + 2;
  for (int slab = wid; slab < nslab; slab += 4) {
    const int key = slab * 16 + kx;
    const bf16_t* kp = ikb + (size_t)key * 64 + 16 * q4;
    const bf16x8 kf0 = *(const bf16x8*)kp, kf1 = *(const bf16x8*)(kp + 8);
    const bool diag = slab >= 2 * qt;
#pragma unroll
    for (int mt = 0; mt < 8; ++mt) {
      f32x4 a = {0.f, 0.f, 0.f, 0.f};
      a = __builtin_amdgcn_mfma_f32_16x16x32_bf16(af[mt][0], kf0, a, 0, 0, 0);
      a = __builtin_amdgcn_mfma_f32_16x16x32_bf16(af[mt][1], kf1, a, 0, 0, 0);
      float sc = 0.f;
      sc = fmaf(wv[mt][0], fmaxf(a[0], 0.f), sc); sc = fmaf(wv[mt][1], fmaxf(a[1], 0.f), sc);
      sc = fmaf(wv[mt][2], fmaxf(a[2], 0.f), sc); sc = fmaf(wv[mt][3], fmaxf(a[3], 0.f), sc);
      sc += 0.0f;
      const int row = 4 * mt + q4;
      const bool ok = !diag || key <= t0 + row;
      const unsigned k20 = f2key(sc) >> 12;
      if (PASS == 0) {
        if (ok) atomicAdd(&hist[row * 512 + (k20 >> 11)], 1u << (((k20 >> 10) & 1u) * 16));
      } else if (PASS == 1) {
        if (ok && (int)(k20 >> 10) == ra[mt]) atomicAdd(&hist[row * 512 + ((k20 & 1023u) >> 1)], 1u << ((k20 & 1u) * 16));
      } else {
        if (ok) {
          const int T20 = ra[mt];
          if ((int)k20 > T20 || ((int)k20 == T20 && !rb_[mt])) { const int pos = atomicAdd(&st[192 + row], 1); selb[(size_t)(t0 + row) * 256 + pos] = (unsigned short)key; }
          else if ((int)k20 == T20) atomicOr(&hist[row * 256 + (key >> 5)], 1u << (key & 31));
        }
      }
    }
  }
}
DEV void topk_scan(unsigned* hist, int* st, int level) {
  const int lane = threadIdx.x & 63, wid = threadIdx.x >> 6;
  for (int i = 0; i < 8; ++i) {
    const int row = wid * 8 + i;
    const int k = level == 0 ? st[row] : st[64 + row];
    const u32x4 w0 = *(const u32x4*)(hist + row * 512 + lane * 8), w1 = *(const u32x4*)(hist + row * 512 + lane * 8 + 4);
    int c[16];
#pragma unroll
    for (int j = 0; j < 4; ++j) { c[2 * j] = (int)(w0[j] & 0xFFFFu); c[2 * j + 1] = (int)(w0[j] >> 16); c[8 + 2 * j] = (int)(w1[j] & 0xFFFFu); c[9 + 2 * j] = (int)(w1[j] >> 16); }
    int tot = 0;
#pragma unroll
    for (int j = 0; j < 16; ++j) tot += c[j];
    int v = tot;
#pragma unroll
    for (int off = 1; off < 64; off <<= 1) { const int t = __shfl_down(v, off); if (lane + off < 64) v += t; }
    const int excl = v - tot;
    if (excl < k && k <= v) {
      int cum = excl, bsel = 0, rsel = 0, csel = 0; bool found = false;
#pragma unroll
      for (int j = 15; j >= 0; --j) { if (!found && cum + c[j] >= k) { bsel = lane * 16 + j; rsel = k - cum; csel = c[j]; found = true; } cum += c[j]; }
      if (level == 0) { st[32 + row] = bsel; st[64 + row] = rsel; }
      else { st[96 + row] = (st[32 + row] << 10) | bsel; st[128 + row] = csel > rsel ? 1 : 0; st[160 + row] = rsel; }
    }
  }
}
DEV void topk_unit(const Params& p, int b, int qt, char* lds) {
  const int tid = threadIdx.x, lane = tid & 63, wid = tid >> 6, kx = lane & 15, q4 = lane >> 4;
  const int t0 = qt * 32; const size_t rb = (size_t)b * S;
  unsigned* hist = (unsigned*)lds; int* st = (int*)(lds + 65536);
  const bf16_t* iq = WSP(bf16_t, OFF_IQ); const bf16_t* ikb = WSP(bf16_t, OFF_IK) + rb * 64; const float* iw = WSP(float, OFF_IW);
  unsigned short* selb = WSP(unsigned short, OFF_SEL) + rb * 256;
  bf16x8 af[8][2]; f32x4 wv[8];
#pragma unroll
  for (int mt = 0; mt < 8; ++mt) {
    const bf16_t* ap = iq + ((rb + t0 + 4 * mt + (kx >> 2)) * 4 + (kx & 3)) * 64 + 16 * q4;
    af[mt][0] = *(const bf16x8*)ap; af[mt][1] = *(const bf16x8*)(ap + 8);
    wv[mt] = *(const f32x4*)(iw + (rb + t0 + 4 * mt + q4) * 4);
  }
  const u32x4 z4 = {0u, 0u, 0u, 0u};
#pragma unroll
  for (int i = 0; i < 16; ++i) *(u32x4*)(lds + (i * 256 + tid) * 16) = z4;
  if (tid < 32) { const int n = t0 + tid + 1; st[tid] = n < 256 ? n : 256; }
  __syncthreads();
  int ra[8], rb2[8];
#pragma unroll
  for (int mt = 0; mt < 8; ++mt) { ra[mt] = 0; rb2[mt] = 0; }
  topk_pass<0>(ikb, selb, t0, qt, af, wv, hist, st, ra, rb2);
  __syncthreads();
  topk_scan(hist, st, 0);
  __syncthreads();
#pragma unroll
  for (int i = 0; i < 16; ++i) *(u32x4*)(lds + (i * 256 + tid) * 16) = z4;
#pragma unroll
  for (int mt = 0; mt < 8; ++mt) ra[mt] = st[32 + 4 * mt + q4];
  __syncthreads();
  topk_pass<1>(ikb, selb, t0, qt, af, wv, hist, st, ra, rb2);
  __syncthreads();
  topk_scan(hist, st, 1);
  __syncthreads();
#pragma unroll
  for (int i = 0; i < 8; ++i) *(u32x4*)(lds + (i * 256 + tid) * 16) = z4;
  if (tid < 32) st[192 + tid] = 0;
#pragma unroll
  for (int mt = 0; mt < 8; ++mt) { ra[mt] = st[96 + 4 * mt + q4]; rb2[mt] = st[128 + 4 * mt + q4]; }
  __syncthreads();
  topk_pass<2>(ikb, selb, t0, qt, af, wv, hist, st, ra, rb2);
  __syncthreads();
  for (int i = 0; i < 8; ++i) {
    const int row = wid * 8 + i;
    if (st[128 + row]) {
      const int r1 = st[160 + row], base = st[row] - r1;
      const u32x4 w = *(const u32x4*)(hist + row * 256 + lane * 4);
      const int pc = __popc(w.x) + __popc(w.y) + __popc(w.z) + __popc(w.w);
      int v = pc;
#pragma unroll
      for (int off = 1; off < 64; off <<= 1) { const int t = __shfl_up(v, off); if (lane >= off) v += t; }
      int rank = v - pc;
#pragma unroll
      for (int j = 0; j < 4; ++j) { unsigned ww = w[j];
        while (ww && rank < r1) { const int bit = __ffs((int)ww) - 1; selb[(size_t)(t0 + row) * 256 + base + rank] = (unsigned short)((lane * 4 + j) * 32 + bit); ++rank; ww &= ww - 1u; } }
    }
  }
  __syncthreads();
}
DEV void ph_topk(const Params& p, char* lds) {
  for (int i = blockIdx.x; i < 512; i += gridDim.x) {
    topk_unit(p, i & 3, i >> 2, lds);
    const int j = 1023 - i;
    topk_unit(p, j & 3, j >> 2, lds);
  }
}
__global__ void __launch_bounds__(256, 2) k_f_topk(Params p) { extern __shared__ __attribute__((aligned(16))) char lds[]; ph_topk(p, lds); }
__global__ void __launch_bounds__(256, 2) k_f_gates(Params p) { extern __shared__ __attribute__((aligned(16))) char lds[]; ph_gates(p, lds); }
__global__ void __launch_bounds__(256, 2) k_f_branch(Params p) { extern __shared__ __attribute__((aligned(16))) char lds[]; ph_branch(p, lds); }
__global__ void __launch_bounds__(256, 2) k_f_out(Params p) { extern __shared__ __attribute__((aligned(16))) char lds[]; ph_out(p, lds); }
__global__ void __launch_bounds__(256, 2) k_f_up(Params p) { extern __shared__ __attribute__((aligned(16))) char lds[]; ph_up(p, lds); }
__global__ void __launch_bounds__(256, 2) k_f_down(Params p) { extern __shared__ __attribute__((aligned(16))) char lds[]; ph_down(p, lds); }
__global__ void __launch_bounds__(256, 2) k_f_transposes(Params p) { extern __shared__ __attribute__((aligned(16))) char lds[]; ph_transposes(p, lds); }
__global__ void __launch_bounds__(256, 2) k_f_gemm1(Params p) { extern __shared__ __attribute__((aligned(16))) char lds[]; ph_gemm1(p, lds); }

extern "C" void kernel_launch(void* const* d_in, const int* in_sizes, int n_in, void* d_out, int out_size, void* d_ws, size_t ws_size, hipStream_t stream) {
  (void)in_sizes; (void)n_in; (void)out_size;
  if (ws_size < OFF_END) { fprintf(stderr, "workspace too small: %zu < %zu\n", ws_size, (size_t)OFF_END); return; }
  Params p{};
  p.x = (const float*)d_in[0]; p.mem = (const float*)d_in[1]; p.g_mix = (const float*)d_in[2]; p.g_mem = (const float*)d_in[3];
  p.w_in = (const float*)d_in[4]; p.w_mem_kv = (const float*)d_in[5]; p.w_gate = (const float*)d_in[6]; p.b_gate = (const float*)d_in[7];
  p.w_branch = (const float*)d_in[8]; p.w_out = (const float*)d_in[9]; p.g_ffn = (const float*)d_in[10]; p.w_group = (const float*)d_in[11];
  p.b_group = (const float*)d_in[12]; p.w_sub = (const float*)d_in[13]; p.b_sub = (const float*)d_in[14]; p.w1 = (const float*)d_in[15];
  p.w3 = (const float*)d_in[16]; p.w2 = (const float*)d_in[17]; p.g_final = (const float*)d_in[18];
  p.out = (float*)d_out; p.ws = (char*)d_ws;
  const int G = 4096;
  k_prep<<<G, 256, 0, stream>>>(p);
  (void)hipFuncSetAttribute((const void*)k_f_transposes, hipFuncAttributeMaxDynamicSharedMemorySize, LDS_BYTES);
  (void)hipFuncSetAttribute((const void*)k_f_gemm1, hipFuncAttributeMaxDynamicSharedMemorySize, LDS_BYTES);
  k_f_transposes<<<512, 256, LDS_BYTES, stream>>>(p);
  k_f_gemm1<<<512, 256, LDS_BYTES, stream>>>(p);
  (void)hipFuncSetAttribute((const void*)k_f_topk, hipFuncAttributeMaxDynamicSharedMemorySize, LDS_BYTES);
  k_f_topk<<<512, 256, LDS_BYTES, stream>>>(p);
  (void)hipFuncSetAttribute((const void*)k_f_attn, hipFuncAttributeMaxDynamicSharedMemorySize, LDS_BYTES);
  k_f_attn<<<512, 256, LDS_BYTES, stream>>>(p);
  k_f_mergeb<<<2048, 256, 0, stream>>>(p);
  (void)hipFuncSetAttribute((const void*)k_f_gates, hipFuncAttributeMaxDynamicSharedMemorySize, LDS_BYTES);
  k_f_gates<<<512, 256, LDS_BYTES, stream>>>(p);
  (void)hipFuncSetAttribute((const void*)k_f_branch, hipFuncAttributeMaxDynamicSharedMemorySize, LDS_BYTES);
  k_f_branch<<<512, 256, LDS_BYTES, stream>>>(p);
  (void)hipFuncSetAttribute((const void*)k_f_out, hipFuncAttributeMaxDynamicSharedMemorySize, LDS_BYTES);
  k_f_out<<<512, 256, LDS_BYTES, stream>>>(p);
  k_route<<<512, 256, 0, stream>>>(p);
  (void)hipFuncSetAttribute((const void*)k_f_up, hipFuncAttributeMaxDynamicSharedMemorySize, LDS_BYTES);
  k_f_up<<<512, 256, LDS_BYTES, stream>>>(p);
  (void)hipFuncSetAttribute((const void*)k_f_down, hipFuncAttributeMaxDynamicSharedMemorySize, LDS_BYTES);
  k_f_down<<<512, 256, LDS_BYTES, stream>>>(p);
  k_final<<<G, 256, 0, stream>>>(p);
}
```

```cpp
#include <hip/hip_runtime.h>
#include <stdint.h>
#include <stdio.h>

#define PROBE 0
#define DEV __device__ __forceinline__
typedef unsigned short bf16_t;
typedef short bf16x8 __attribute__((ext_vector_type(8)));
typedef float f32x4 __attribute__((ext_vector_type(4)));
typedef float f32x2 __attribute__((ext_vector_type(2)));
typedef unsigned u32x4 __attribute__((ext_vector_type(4)));
typedef unsigned u32x2 __attribute__((ext_vector_type(2)));
typedef __bf16 bf16x2_t __attribute__((ext_vector_type(2)));

DEV int tid_opaque() { int t = threadIdx.x; asm volatile("" : "+v"(t)); return t; }
#define TIDX tid_opaque()
DEV float bf2f(bf16_t v) { return __uint_as_float(((unsigned)v) << 16); }
DEV unsigned pk2(float lo, float hi) { f32x2 v = {lo, hi}; bf16x2_t b = __builtin_convertvector(v, bf16x2_t); return __builtin_bit_cast(unsigned, b); }
DEV bf16_t f2bf(float f) { return (bf16_t)(pk2(f, 0.f) & 0xFFFFu); }
DEV u32x2 pk4(f32x4 v) { u32x2 r; r.x = pk2(v[0], v[1]); r.y = pk2(v[2], v[3]); return r; }
DEV f32x4 unpk4(u32x2 r) { f32x4 v; v[0] = __uint_as_float(r.x << 16); v[1] = __uint_as_float(r.x & 0xFFFF0000u); v[2] = __uint_as_float(r.y << 16); v[3] = __uint_as_float(r.y & 0xFFFF0000u); return v; }
DEV u32x4 pk8(const f32x4& a, const f32x4& b) { u32x4 r; r.x = pk2(a[0], a[1]); r.y = pk2(a[2], a[3]); r.z = pk2(b[0], b[1]); r.w = pk2(b[2], b[3]); return r; }
DEV void unpk8(const u32x4& r, f32x4& a, f32x4& b) {
  a[0] = __uint_as_float(r.x << 16); a[1] = __uint_as_float(r.x & 0xFFFF0000u); a[2] = __uint_as_float(r.y << 16); a[3] = __uint_as_float(r.y & 0xFFFF0000u);
  b[0] = __uint_as_float(r.z << 16); b[1] = __uint_as_float(r.z & 0xFFFF0000u); b[2] = __uint_as_float(r.w << 16); b[3] = __uint_as_float(r.w & 0xFFFF0000u); }

DEV float wave_sum(float v) {
#pragma unroll
  for (int o = 32; o >= 1; o >>= 1) v += __shfl_xor(v, o);
  return v;
}

constexpr int NB = 4, S = 8192, T = NB * S, D = 1024, S_ = S;
constexpr int NTH = 512, NWV = 8;
constexpr int INW = 6212;
constexpr float RMS_EPS = 1e-6f;
constexpr int C_AQ = 0, C_AK = 512, C_AV = 640, C_IQ = 768, C_IK = 1024, C_BQ = 1088, C_BK = 2624, C_BV = 4160, C_MQ = 5696, C_IW = 6208, C_END = 6212;

constexpr size_t MiB = 1048576;
constexpr size_t OFF_BAR = 0;
constexpr size_t OFF_CNT = 16384;
constexpr size_t OFF_WR = 65536;
constexpr size_t OFF_WIN = 1 * MiB;
constexpr size_t OFF_WG = OFF_WIN + 13 * MiB;
constexpr size_t OFF_WB = OFF_WG + 6 * MiB;
constexpr size_t OFF_WO = OFF_WB + 3 * MiB;
constexpr size_t OFF_WM = OFF_WO + 2 * MiB;
constexpr size_t OFF_W13 = OFF_WM + 2 * MiB;
constexpr size_t OFF_W2 = OFF_W13 + 32 * MiB;
constexpr size_t OFF_ROPE = OFF_W2 + 16 * MiB;
constexpr size_t OFF_MEMN = OFF_ROPE + 2 * MiB;
constexpr size_t OFF_KV = OFF_MEMN + 2 * MiB;
constexpr size_t OFF_LIST = OFF_KV + 2 * MiB;
constexpr size_t OFF_CW = OFF_LIST + 2 * MiB;
constexpr size_t OFF_IW = OFF_CW + 1 * MiB;
constexpr size_t OFF_LSE = OFF_IW + 1 * MiB;
constexpr size_t OFF_SEL = OFF_LSE + 3 * MiB;
constexpr size_t OFF_AQ = OFF_SEL + 16 * MiB;
constexpr size_t OFF_AK = OFF_AQ + 32 * MiB;
constexpr size_t OFF_AV = OFF_AK + 8 * MiB;
constexpr size_t OFF_IQ = OFF_AV + 8 * MiB;
constexpr size_t OFF_IK = OFF_IQ + 16 * MiB;
constexpr size_t OFF_BQ = OFF_IK + 4 * MiB;
constexpr size_t OFF_MQ = OFF_BQ + 96 * MiB;
constexpr size_t OFF_BK = OFF_MQ + 32 * MiB;
constexpr size_t OFF_BV = OFF_BK + 96 * MiB;
constexpr size_t OFF_END = OFF_BV + 96 * MiB;
constexpr size_t OFF_YB = OFF_AK, OFF_MERGED = OFF_BQ, OFF_MOE = OFF_BQ, OFF_GATES = OFF_BK, OFF_HN = OFF_BK, OFF_HID = OFF_BK + 64 * MiB;
static_assert(OFF_END <= 512 * MiB, "workspace overflow");

struct Params {
  const float *x, *mem, *g_mix, *g_mem, *w_in, *w_mem_kv, *w_gate, *b_gate, *w_branch, *w_out, *g_ffn, *w_group, *b_group, *w_sub, *b_sub, *w1, *w3, *w2, *g_final;
  float* out;
  char* ws;
};
#define WSP(T_, off) ((T_*)(p.ws + (off)))

DEV void ph_prep(const Params& p) {
  const int lane = TIDX & 63, gw = (blockIdx.x * NTH + TIDX) >> 6, nw = (gridDim.x * NTH) >> 6;
  bf16_t* n = (bf16_t*)p.out;
  bf16_t* memn = WSP(bf16_t, OFF_MEMN);
  for (int r = gw; r < T + NB * 256; r += nw) {
    const bool isx = r < T;
    const float* src = isx ? p.x + (size_t)r * D : p.mem + (size_t)(r - T) * D;
    const float* g = isx ? p.g_mix : p.g_mem;
    bf16_t* dst = isx ? n + (size_t)r * D : memn + (size_t)(r - T) * D;
    f32x4 v[4]; float ss = 0.f;
#pragma unroll
    for (int i = 0; i < 4; ++i) { v[i] = *(const f32x4*)(src + i * 256 + lane * 4); ss += v[i][0] * v[i][0] + v[i][1] * v[i][1] + v[i][2] * v[i][2] + v[i][3] * v[i][3]; }
    ss = wave_sum(ss);
    const float rstd = 1.0f / sqrtf(ss * (1.0f / D) + RMS_EPS);
#pragma unroll
    for (int i = 0; i < 4; ++i) { const f32x4 gg = *(const f32x4*)(g + i * 256 + lane * 4); f32x4 o = v[i] * rstd * gg; *(u32x2*)(dst + i * 256 + lane * 4) = pk4(o); }
  }
  f32x2* rope = WSP(f32x2, OFF_ROPE);
  for (int i = blockIdx.x * NTH + TIDX; i < S * 32; i += gridDim.x * NTH) {
    const int pos = i >> 5, j = i & 31;
    const double inv = exp2(-(double)j * (13.287712379549449 / 32.0));
    const double ang = (double)pos * inv;
    double rev = ang * 0.15915494309189535; rev -= floor(rev);
    const float rf = (float)rev;
    f32x2 cs; cs.x = __builtin_amdgcn_cosf(rf); cs.y = __builtin_amdgcn_sinf(rf);
    rope[i] = cs;
  }
  bf16_t* wr = WSP(bf16_t, OFF_WR);
  for (int i = blockIdx.x * NTH + TIDX; i < 32 * 1024; i += gridDim.x * NTH) {
    const int n = i >> 10, k = i & 1023;
    float w = 0.f;
    if (n < 4) w = p.w_group[k * 4 + n]; else if (n < 20) w = p.w_sub[((size_t)((n - 4) >> 2) * 1024 + k) * 4 + ((n - 4) & 3)];
    w *= p.g_ffn[k];
    const bf16_t hi = f2bf(w); const bf16_t lo = f2bf(w - bf2f(hi));
    wr[i] = hi; wr[32 * 1024 + i] = lo;
  }
}

DEV bool g1_dest(const Params& p, int c, bf16_t*& base, int& ld, int& lc, bool& rope) {
  if (c < C_AK) { base = WSP(bf16_t, OFF_AQ); ld = 512; lc = c - C_AQ; rope = true; }
  else if (c < C_AV) { base = WSP(bf16_t, OFF_AK); ld = 128; lc = c - C_AK; rope = true; }
  else if (c < C_IQ) { base = WSP(bf16_t, OFF_AV); ld = 128; lc = c - C_AV; rope = false; }
  else if (c < C_IK) { base = WSP(bf16_t, OFF_IQ); ld = 256; lc = c - C_IQ; rope = true; }
  else if (c < C_BQ) { base = WSP(bf16_t, OFF_IK); ld = 64; lc = c - C_IK; rope = true; }
  else if (c < C_BK) { base = WSP(bf16_t, OFF_BQ); ld = 1536; lc = c - C_BQ; rope = true; }
  else if (c < C_BV) { base = WSP(bf16_t, OFF_BK); ld = 1536; lc = c - C_BK; rope = true; }
  else if (c < C_MQ) { base = WSP(bf16_t, OFF_BV); ld = 1536; lc = c - C_BV; rope = false; }
  else if (c < C_IW) { base = WSP(bf16_t, OFF_MQ); ld = 512; lc = c - C_MQ; rope = false; }
  else return false;
  return true;
}
DEV int src_col(int c) { return c < C_BQ ? c : (c < C_IW ? c + 4 : c - C_IW + 1088); }

DEV unsigned f2key(float s) { const unsigned u = __float_as_uint(s); return (u & 0x80000000u) ? ~u : (u | 0x80000000u); }

DEV void route_block(const Params& p, int blk, char* lds, bool dry = false) {
  int* tok_e = (int*)lds;
  float* tok_w = (float*)(lds + 1024);
  int* lcnt = (int*)(lds + 2048);
  int* gbase = (int*)(lds + 2112);
  int* rank = (int*)(lds + 2176);
  const int tid = TIDX, lane = tid & 63, wid = tid >> 6;
  const float* h1 = p.out; bf16_t* hn = WSP(bf16_t, OFF_HN);
  if (tid < 16) lcnt[tid] = 0;
  {
    const int fr = lane & 15, fq = lane >> 4;
    const int tok = blk * 128 + wid * 16 + fr;
    const float* xr = h1 + (size_t)tok * D + 8 * fq;
    const bf16_t* wh = WSP(bf16_t, OFF_WR) + (size_t)fr * 1024 + 8 * fq;
    f32x4 lg0 = {0.f, 0.f, 0.f, 0.f}, lg1 = {0.f, 0.f, 0.f, 0.f}; float ss = 0.f;
#pragma unroll 2
    for (int ks = 0; ks < 32; ++ks) {
      const f32x4 x0 = *(const f32x4*)(xr + 32 * ks), x1 = *(const f32x4*)(xr + 32 * ks + 4);
      const bf16x8 wh0 = *(const bf16x8*)(wh + 32 * ks), wh1 = *(const bf16x8*)(wh + 16 * 1024 + 32 * ks);
      const bf16x8 wl0 = *(const bf16x8*)(wh + 32 * 1024 + 32 * ks), wl1 = *(const bf16x8*)(wh + 48 * 1024 + 32 * ks);
      ss += x0[0] * x0[0] + x0[1] * x0[1] + x0[2] * x0[2] + x0[3] * x0[3] + x1[0] * x1[0] + x1[1] * x1[1] + x1[2] * x1[2] + x1[3] * x1[3];
      u32x4 ph; ph.x = pk2(x0[0], x0[1]); ph.y = pk2(x0[2], x0[3]); ph.z = pk2(x1[0], x1[1]); ph.w = pk2(x1[2], x1[3]);
      f32x4 h0, h1v; unpk8(ph, h0, h1v);
      const f32x4 r0 = x0 - h0, r1 = x1 - h1v;
      u32x4 pl; pl.x = pk2(r0[0], r0[1]); pl.y = pk2(r0[2], r0[3]); pl.z = pk2(r1[0], r1[1]); pl.w = pk2(r1[2], r1[3]);
      const bf16x8 xh = __builtin_bit_cast(bf16x8, ph), xl = __builtin_bit_cast(bf16x8, pl);
      lg0 = __builtin_amdgcn_mfma_f32_16x16x32_bf16(wh0, xh, lg0, 0, 0, 0); lg0 = __builtin_amdgcn_mfma_f32_16x16x32_bf16(wl0, xh, lg0, 0, 0, 0); lg0 = __builtin_amdgcn_mfma_f32_16x16x32_bf16(wh0, xl, lg0, 0, 0, 0);
      lg1 = __builtin_amdgcn_mfma_f32_16x16x32_bf16(wh1, xh, lg1, 0, 0, 0); lg1 = __builtin_amdgcn_mfma_f32_16x16x32_bf16(wl1, xh, lg1, 0, 0, 0); lg1 = __builtin_amdgcn_mfma_f32_16x16x32_bf16(wh1, xl, lg1, 0, 0, 0);
    }
    ss += __shfl_xor(ss, 16); ss += __shfl_xor(ss, 32);
    const float rstd = 1.0f / sqrtf(ss * (1.0f / D) + RMS_EPS);
    float* lgs = (float*)(lds + 4096) + wid * 512;
    *(f32x4*)(lgs + fr * 32 + 4 * fq) = lg0; *(f32x4*)(lgs + fr * 32 + 16 + 4 * fq) = lg1;
    float lgv[20];
#pragma unroll
    for (int j = 0; j < 5; ++j) { const f32x4 v = *(const f32x4*)(lgs + fr * 32 + 4 * j); lgv[4 * j] = v[0]; lgv[4 * j + 1] = v[1]; lgv[4 * j + 2] = v[2]; lgv[4 * j + 3] = v[3]; }
    {
      float gl[4];
#pragma unroll
      for (int g = 0; g < 4; ++g) gl[g] = lgv[g] * rstd + p.b_group[g];
      int gs = 0; float gm = gl[0];
#pragma unroll
      for (int g = 1; g < 4; ++g) if (gl[g] > gm) { gm = gl[g]; gs = g; }
      float gden = 0.f;
#pragma unroll
      for (int g = 0; g < 4; ++g) gden += __expf(gl[g] - gm);
      const float gw = 1.0f / gden;
      float sl[4];
#pragma unroll
      for (int e = 0; e < 4; ++e) { float v = 0.f;
#pragma unroll
        for (int g = 0; g < 4; ++g) v = (gs == g) ? lgv[4 + 4 * g + e] * rstd + p.b_sub[g * 4 + e] : v;
        sl[e] = v; }
      int e0 = 0; float m0 = sl[0];
#pragma unroll
      for (int e = 1; e < 4; ++e) if (sl[e] > m0) { m0 = sl[e]; e0 = e; }
      int e1 = -1; float m1 = -INFINITY;
#pragma unroll
      for (int e = 0; e < 4; ++e) if (e != e0 && sl[e] > m1) { m1 = sl[e]; e1 = e; }
      const float p1 = __expf(m1 - m0);
      const float w0 = gw / (1.0f + p1), w1 = gw * p1 / (1.0f + p1);
      if (fq == 0) { const int tl = wid * 16 + fr; tok_e[tl * 2] = gs * 4 + e0; tok_e[tl * 2 + 1] = gs * 4 + e1; tok_w[tl * 2] = w0; tok_w[tl * 2 + 1] = w1; }
    }
#pragma unroll 4
    for (int ks = 0; ks < 32; ++ks) {
      const f32x4 x0 = *(const f32x4*)(xr + 32 * ks), x1 = *(const f32x4*)(xr + 32 * ks + 4);
      const f32x4 g0 = *(const f32x4*)(p.g_ffn + 32 * ks + 8 * fq), g1 = *(const f32x4*)(p.g_ffn + 32 * ks + 8 * fq + 4);
      *(u32x4*)(hn + (size_t)tok * D + 32 * ks + 8 * fq) = pk8(x0 * rstd * g0, x1 * rstd * g1);
    }
  }
  __syncthreads();
  if (tid < 256) rank[tid] = atomicAdd(&lcnt[tok_e[tid]], 1);
  __syncthreads();
  if (tid < 16 && !dry) gbase[tid] = (int)__hip_atomic_fetch_add(WSP(unsigned, OFF_CNT) + tid, (unsigned)lcnt[tid], __ATOMIC_RELAXED, __HIP_MEMORY_SCOPE_AGENT);
  __syncthreads();
  if (tid < 256 && !dry) {
    const int e = tok_e[tid], ent = (blk * 128 + (tid >> 1)) * 2 + (tid & 1);
    WSP(int, OFF_LIST)[(size_t)e * T + gbase[e] + rank[tid]] = ent;
    WSP(float, OFF_CW)[ent] = tok_w[tid];
  }
  __syncthreads();
}
DEV void ph_final(const Params& p, bool dry = false) {
  const int lane = TIDX & 63, gw = (blockIdx.x * NTH + TIDX) >> 6, nw = (gridDim.x * NTH) >> 6;
  const bf16_t* moe = WSP(bf16_t, OFF_MOE);
  for (int r = gw; r < T; r += nw) {
    f32x4 v[4]; float ss = 0.f;
#pragma unroll
    for (int i = 0; i < 4; ++i) {
      const int c = i * 256 + lane * 4;
      v[i] = *(const f32x4*)(p.out + (size_t)r * D + c) + unpk4(*(const u32x2*)(moe + (size_t)(2 * r) * D + c)) + unpk4(*(const u32x2*)(moe + (size_t)(2 * r + 1) * D + c));
      ss += v[i][0] * v[i][0] + v[i][1] * v[i][1] + v[i][2] * v[i][2] + v[i][3] * v[i][3];
    }
    ss = wave_sum(ss);
    const float rstd = 1.0f / sqrtf(ss * (1.0f / D) + RMS_EPS);
#pragma unroll
    for (int i = 0; i < 4; ++i) { const int c = i * 256 + lane * 4; float* dst = dry ? WSP(float, OFF_HID) + ((size_t)r * D & (8 * MiB - 1)) + c : p.out + (size_t)r * D + c; *(f32x4*)dst = v[i] * rstd * *(const f32x4*)(p.g_final + c); }
  }
}


constexpr int LDS_BYTES = 143360;
constexpr int NIN_PAD = 6400;
__host__ __device__ __forceinline__ int perm256(int rho) { const int r = rho & 255; return (rho & ~255) + ((r >> 5) & 3) * 64 + (r >> 7) * 32 + ((r >> 2) & 3) * 8 + ((r >> 4) & 1) * 4 + (r & 3); }

DEV void ph_transposes(const Params& p, char* lds) {
  const int tid = TIDX, half = tid >> 8, t = tid & 255;
  float* tile = (float*)(lds + half * 16640);
  constexpr int J0 = 100 * 16, J1 = J0 + 48 * 16, J2 = J1 + 3 * 16 * 8, J3 = J2 + 256, J4 = J3 + 256, J5 = J4 + 16 * 256, J6 = J5 + 16 * 128;
  static_assert((J6 & 1) == 0, "job count must be even");
  for (int jb = blockIdx.x; jb < J6 / 2; jb += gridDim.x) {
    const int job = jb * 2 + half;
    const float* s0; const float* s1 = nullptr; int lds_ = 1024, ldd = 1024, n0, k0, mode = 1; bf16_t* dst;
    if (job < J0) { const int nt = job / 16, kt = job % 16; s0 = p.w_in; lds_ = INW; dst = WSP(bf16_t, OFF_WIN); n0 = nt * 64; k0 = kt * 64; mode = 0; }
    else if (job < J1) { const int j = job - J0, nt = j / 16, kt = j % 16; s0 = p.w_gate; lds_ = 3072; dst = WSP(bf16_t, OFF_WG); n0 = nt * 64; k0 = kt * 64; }
    else if (job < J2) { const int j = job - J1, br = j / 128, r = j % 128, nt = r / 8, kt = r % 8; s0 = p.w_branch + (size_t)br * 512 * 1024; dst = WSP(bf16_t, OFF_WB) + (size_t)br * 1024 * 512; ldd = 512; n0 = nt * 64; k0 = kt * 64; }
    else if (job < J3) { const int j = job - J2, nt = j / 16, kt = j % 16; s0 = p.w_out; dst = WSP(bf16_t, OFF_WO); n0 = nt * 64; k0 = kt * 64; }
    else if (job < J4) { const int j = job - J3, nt = j / 16, kt = j % 16; s0 = p.w_mem_kv; dst = WSP(bf16_t, OFF_WM); n0 = nt * 64; k0 = kt * 64; }
    else if (job < J5) { const int j = job - J4, e = j / 256, r = j % 256, nt = r / 16, kt = r % 16; s0 = p.w1 + (size_t)e * 1024 * 512; s1 = p.w3 + (size_t)e * 1024 * 512; lds_ = 512;
      dst = WSP(bf16_t, OFF_W13) + (size_t)e * 1024 * 1024; n0 = nt * 64; k0 = kt * 64; mode = 2; }
    else { const int j = job - J5, e = j / 128, r = j % 128, nt = r / 8, kt = r % 8; s0 = p.w2 + (size_t)e * 512 * 1024; dst = WSP(bf16_t, OFF_W2) + (size_t)e * 1024 * 512; ldd = 512; n0 = nt * 64; k0 = kt * 64; }
    const int v = perm256(n0 + 4 * (t & 15));
    const float* sp; bool zero = false;
    if (mode == 0) { zero = v >= C_END; sp = s0 + (zero ? 0 : src_col(v)); }
    else if (mode == 1) sp = s0 + v;
    else { const int hidn = (v >> 8) * 128 + ((v >> 6) & 3) * 32 + (v & 31); sp = (((v >> 5) & 1) ? s1 : s0) + hidn; }
#pragma unroll
    for (int i = 0; i < 4; ++i) { const int kk = (t >> 4) + 16 * i; const f32x4 x = zero ? (f32x4){0.f, 0.f, 0.f, 0.f} : *(const f32x4*)(sp + (size_t)(k0 + kk) * lds_);
      float* tp = tile + kk * 65 + 4 * (t & 15); tp[0] = x[0]; tp[1] = x[1]; tp[2] = x[2]; tp[3] = x[3]; }
    __syncthreads();
    const int n = t >> 2, kc = (t & 3) * 16;
    float vv[16];
#pragma unroll
    for (int j = 0; j < 16; ++j) vv[j] = tile[(kc + j) * 65 + n];
    u32x4 o0, o1;
    o0.x = pk2(vv[0], vv[1]); o0.y = pk2(vv[2], vv[3]); o0.z = pk2(vv[4], vv[5]); o0.w = pk2(vv[6], vv[7]);
    o1.x = pk2(vv[8], vv[9]); o1.y = pk2(vv[10], vv[11]); o1.z = pk2(vv[12], vv[13]); o1.w = pk2(vv[14], vv[15]);
    bf16_t* dd = dst + (size_t)(n0 + n) * ldd + k0 + kc;
    *(u32x4*)dd = o0; *(u32x4*)(dd + 8) = o1;
    __syncthreads();
  }
}
typedef __attribute__((address_space(3))) unsigned char* ldsb_t;
constexpr int HTB = 128 * 64 * 2;
DEV int lds_byte(int r, int c) { return r * 128 + ((((c >> 3) ^ (r >> 1)) & 7) << 4); }
DEV void stage_rc(int b, int& R, int& C) { R = b >> 7; C = ((((b >> 4) & 7) ^ (R >> 1)) & 7) * 8; }
struct Unit { int pm, pn, aux, ne; };
struct StaticOrder {
  int nM, nN, nwg, G, c;
  DEV void init(int nM_, int nN_, int G_, int c_) { nM = nM_; nN = nN_; nwg = nM * nN; G = G_; c = c_; }
  DEV bool next(int i, int& pm, int& pn) const {
    const long L = (long)i * G + c; if (L >= nwg) return false;
    int wgid = (int)L; { const int q = nwg / 8, r = nwg % 8, xcd = wgid % 8, off = wgid / 8; wgid = (xcd < r ? xcd * (q + 1) : r * (q + 1) + (xcd - r) * q) + off; }
    const int nig = 8 * nN, gid = wgid / nig, fm = gid * 8, gsz = (nM - fm) < 8 ? (nM - fm) : 8;
    pm = fm + ((wgid % nig) % gsz); pn = (wgid % nig) / gsz; return true;
  }
};
typedef f32x4 acc_t[2][2][4][2];
template <class DD>
DEV void gemm256(ldsb_t lds, const DD& d) {
  const int tid = TIDX, wid = __builtin_amdgcn_readfirstlane(tid >> 6), lane = tid & 63, wr = wid >> 2, wc = wid & 3, fr = lane & 15, fq = lane >> 4;
  const int K = d.K, nt = K / 64;
  int Rst[2]; unsigned Cst[2], voffB[2];
#pragma unroll
  for (int i = 0; i < 2; ++i) { int R, C; stage_rc(tid * 16 + i * 8192, R, C); Rst[i] = R; Cst[i] = (unsigned)C * 2u; voffB[i] = (unsigned)(R * K + C) * 2u; }
  const size_t kstep = 128, hstep = (size_t)128 * K * 2;
  const unsigned ldsw = (unsigned)wid * 1024u;
  const int aoff = lds_byte(wr * 64 + fr, fq * 8), boff = lds_byte(wc * 32 + fr, fq * 8);
#define G_SA(b, h) (((b) * 2 + (h)) * HTB)
#define G_SB(b, h) ((4 + (b) * 2 + (h)) * HTB)
#define G_STAGEB(bufoff, gbase) do { _Pragma("unroll") for (int _i = 0; _i < 2; ++_i) \
    __builtin_amdgcn_global_load_lds((const unsigned*)((const char*)(gbase) + voffB[_i]), (__attribute__((address_space(3))) unsigned*)(lds + (bufoff) + ldsw + _i * 8192), 16, 0, 0); } while (0)
#define G_STAGEA(bufoff, gbase, ao, h, kb) do { _Pragma("unroll") for (int _i = 0; _i < 2; ++_i) \
    __builtin_amdgcn_global_load_lds((const unsigned*)((const char*)(gbase) + (ao)[h][_i] + (kb)), (__attribute__((address_space(3))) unsigned*)(lds + (bufoff) + ldsw + _i * 8192), 16, 0, 0); } while (0)
#define G_LDA(dst, b, h) do { _Pragma("unroll") for (int m = 0; m < 4; ++m) _Pragma("unroll") for (int k = 0; k < 2; ++k) dst[m][k] = *(const __attribute__((address_space(3))) bf16x8*)(lds + G_SA(b, h) + ((aoff ^ (k << 6)) + m * 2048)); } while (0)
#define G_LDB(dst, b, h) do { _Pragma("unroll") for (int n = 0; n < 2; ++n) _Pragma("unroll") for (int k = 0; k < 2; ++k) dst[n][k] = *(const __attribute__((address_space(3))) bf16x8*)(lds + G_SB(b, h) + ((boff ^ (k << 6)) + n * 2048)); } while (0)
#define G_MMA(ai, bj, At, Bt) do { __builtin_amdgcn_s_setprio(1); _Pragma("unroll") for (int m = 0; m < 4; ++m) _Pragma("unroll") for (int n = 0; n < 2; ++n) _Pragma("unroll") for (int k = 0; k < 2; ++k) \
    acc[ai][bj][m][n] = __builtin_amdgcn_mfma_f32_16x16x32_bf16(Bt[n][k], At[m][k], acc[ai][bj][m][n], 0, 0, 0); __builtin_amdgcn_s_setprio(0); } while (0)
#define G_WAIT_V(n) asm volatile("s_waitcnt vmcnt(" #n ")" ::: "memory")
#define G_WAIT_L(n) asm volatile("s_waitcnt lgkmcnt(" #n ")" ::: "memory")
#define G_BAR __builtin_amdgcn_s_barrier()
#define G_SCHED __builtin_amdgcn_sched_barrier(0)
#define G_ZERO() _Pragma("unroll") for (int a_ = 0; a_ < 2; ++a_) _Pragma("unroll") for (int b_ = 0; b_ < 2; ++b_) _Pragma("unroll") for (int m_ = 0; m_ < 4; ++m_) _Pragma("unroll") for (int n_ = 0; n_ < 2; ++n_) acc[a_][b_][m_][n_] = (f32x4){0.f, 0.f, 0.f, 0.f}
  Unit cur, nxt; int ui = 0;
  if (!d.next(0, cur)) return;
  acc_t acc; G_ZERO();
  bf16x8 At[4][2], B0[2][2], B1[2][2];
  unsigned aoC[2][2], aoN[2][2];
#pragma unroll
  for (int h = 0; h < 2; ++h)
#pragma unroll
    for (int i = 0; i < 2; ++i) aoC[h][i] = d.arow(cur, h * 128 + Rst[i]) + Cst[i];
  const char* cA = d.abase(cur); const char* cB = d.bbase(cur);
  G_STAGEB(G_SB(0, 0), cB); G_STAGEA(G_SA(0, 0), cA, aoC, 0, 0); G_STAGEB(G_SB(0, 1), cB + hstep); G_STAGEA(G_SA(0, 1), cA, aoC, 1, 0);
  if (wr == 1) G_BAR;
  G_WAIT_V(4); G_BAR;
  G_STAGEB(G_SB(1, 0), cB + kstep); G_STAGEA(G_SA(1, 0), cA, aoC, 0, kstep); G_STAGEB(G_SB(1, 1), cB + hstep + kstep);
  G_WAIT_V(6); G_BAR;
  for (;;) {
    const bool has_next = d.next(ui + 1, nxt);
    const char* nA = has_next ? d.abase(nxt) : cA; const char* nB = has_next ? d.bbase(nxt) : cB;
#pragma unroll
    for (int h = 0; h < 2; ++h)
#pragma unroll
      for (int i = 0; i < 2; ++i) aoN[h][i] = has_next ? d.arow(nxt, h * 128 + Rst[i]) + Cst[i] : aoC[h][i];
    for (int t = 0; t < nt; t += 2) {
      const bool last = (t == nt - 2);
      const size_t k1 = (size_t)(t + 1) * kstep;
      const size_t k2 = last ? 0 : (size_t)(t + 2) * kstep, k3 = k2 + kstep;
      const char* a2 = last ? nA : cA; const char* b2 = last ? nB : cB + k2; const char* b3 = b2 + kstep;
      unsigned ao2[2][2];
#pragma unroll
      for (int h = 0; h < 2; ++h)
#pragma unroll
        for (int i = 0; i < 2; ++i) ao2[h][i] = last ? aoN[h][i] : aoC[h][i];
      G_LDB(B0, 0, 0); G_SCHED; G_LDA(At, 0, 0); G_STAGEA(G_SA(1, 1), cA, aoC, 1, k1);
      G_WAIT_L(8); G_BAR; G_WAIT_L(0); G_MMA(0, 0, At, B0); G_BAR; G_SCHED;
      G_LDB(B1, 0, 1); G_STAGEB(G_SB(0, 0), b2);
      G_BAR; G_WAIT_L(0); G_MMA(0, 1, At, B1); G_BAR;
      G_LDA(At, 0, 1); G_STAGEA(G_SA(0, 0), a2, ao2, 0, k2);
      G_BAR; G_WAIT_L(0); G_MMA(1, 0, At, B0); G_BAR; G_SCHED;
      G_STAGEB(G_SB(0, 1), b2 + hstep);
      G_WAIT_V(6); G_BAR; G_MMA(1, 1, At, B1); G_BAR;
      G_LDB(B0, 1, 0); G_SCHED; G_LDA(At, 1, 0); G_STAGEA(G_SA(0, 1), a2, ao2, 1, k2);
      G_WAIT_L(8); G_BAR; G_WAIT_L(0); G_MMA(0, 0, At, B0); G_BAR; G_SCHED;
      G_LDB(B1, 1, 1); G_STAGEB(G_SB(1, 0), b3);
      G_BAR; G_WAIT_L(0); G_MMA(0, 1, At, B1); G_BAR;
      G_LDA(At, 1, 1); G_STAGEA(G_SA(1, 0), a2, ao2, 0, k3);
      G_BAR; G_WAIT_L(0); G_MMA(1, 0, At, B0); G_BAR; G_SCHED;
      G_STAGEB(G_SB(1, 1), b3 + hstep);
      G_WAIT_V(6); G_BAR; G_MMA(1, 1, At, B1); G_BAR;
    }
    d.epi(acc, cur, wr, wc, fr, fq);
    if (!has_next) break;
    G_ZERO();
    cur = nxt; cA = nA; cB = nB; ++ui;
#pragma unroll
    for (int h = 0; h < 2; ++h)
#pragma unroll
      for (int i = 0; i < 2; ++i) aoC[h][i] = aoN[h][i];
  }
  G_WAIT_V(0);
  if (wr == 0) G_BAR;
  G_BAR;
}

struct DGemm1 {
  const Params& p; int K; StaticOrder S;
  DEV bool next(int i, Unit& u) const { return S.next(i, u.pm, u.pn); }
  DEV const char* abase(const Unit&) const { return (const char*)p.out; }
  DEV unsigned arow(const Unit& u, int r) const { return (unsigned)(u.pm * 256 + r) * 2048u; }
  DEV const char* bbase(const Unit& u) const { return p.ws + OFF_WIN + (size_t)u.pn * 256 * 2048; }
  DEV void epi(const acc_t& acc, const Unit& u, int wr, int wc, int fr, int fq) const {
    const int c0 = u.pn * 256 + wc * 64;
    if (c0 < C_IW) {
      bf16_t* base; int ld, lc; bool rope; g1_dest(p, c0, base, ld, lc, rope);
      const f32x2* ropet = WSP(f32x2, OFF_ROPE);
#pragma unroll
      for (int ai = 0; ai < 2; ++ai)
#pragma unroll
        for (int m = 0; m < 4; ++m) {
          const int row = u.pm * 256 + ai * 128 + wr * 64 + m * 16 + fr;
          f32x4 lo[2] = {acc[ai][0][m][0], acc[ai][0][m][1]}, hi[2] = {acc[ai][1][m][0], acc[ai][1][m][1]};
          if (rope) {
            const int pos = row & (S_ - 1);
#pragma unroll
            for (int n = 0; n < 2; ++n) {
              const f32x4 t0 = *(const f32x4*)(ropet + pos * 32 + 8 * fq + 4 * n), t1 = *(const f32x4*)(ropet + pos * 32 + 8 * fq + 4 * n + 2);
              const float cs[4] = {t0[0], t0[2], t1[0], t1[2]}, sn[4] = {t0[1], t0[3], t1[1], t1[3]};
              const f32x4 l = lo[n], h = hi[n];
#pragma unroll
              for (int e = 0; e < 4; ++e) { lo[n][e] = l[e] * cs[e] - h[e] * sn[e]; hi[n][e] = h[e] * cs[e] + l[e] * sn[e]; }
            }
          }
          bf16_t* dst = base + (size_t)row * ld + lc + 8 * fq;
          __builtin_nontemporal_store(pk8(lo[0], lo[1]), (u32x4*)dst); __builtin_nontemporal_store(pk8(hi[0], hi[1]), (u32x4*)(dst + 32));
        }
    } else if (c0 == C_IW) {
      if (fq == 0) {
#pragma unroll
        for (int ai = 0; ai < 2; ++ai)
#pragma unroll
          for (int m = 0; m < 4; ++m) { const int row = u.pm * 256 + ai * 128 + wr * 64 + m * 16 + fr; *(f32x4*)(WSP(float, OFF_IW) + (size_t)row * 4) = acc[ai][0][m][0]; }
      }
    }
  }
};
struct DMemKV {
  const Params& p; int K;
  DEV bool next(int i, Unit& u) const { const int j = (int)blockIdx.x - ((int)gridDim.x - 16); if (i != 0 || j < 0) return false; u.pm = j >> 2; u.pn = j & 3; return true; }
  DEV const char* abase(const Unit&) const { return p.ws + OFF_MEMN; }
  DEV unsigned arow(const Unit& u, int r) const { return (unsigned)(u.pm * 256 + r) * 2048u; }
  DEV const char* bbase(const Unit& u) const { return p.ws + OFF_WM + (size_t)u.pn * 256 * 2048; }
  DEV void epi(const acc_t& acc, const Unit& u, int wr, int wc, int fr, int fq) const {
    bf16_t* kv = WSP(bf16_t, OFF_KV);
#pragma unroll
    for (int ai = 0; ai < 2; ++ai)
#pragma unroll
      for (int m = 0; m < 4; ++m) { const int row = u.pm * 256 + ai * 128 + wr * 64 + m * 16 + fr;
#pragma unroll
        for (int bj = 0; bj < 2; ++bj) *(u32x4*)(kv + (size_t)row * 1024 + u.pn * 256 + wc * 64 + bj * 32 + 8 * fq) = pk8(acc[ai][bj][m][0], acc[ai][bj][m][1]); }
  }
};
struct DGates {
  const Params& p; int K; StaticOrder S;
  DEV bool next(int i, Unit& u) const { return S.next(i, u.pm, u.pn); }
  DEV const char* abase(const Unit&) const { return (const char*)p.out; }
  DEV unsigned arow(const Unit& u, int r) const { return (unsigned)(u.pm * 256 + r) * 2048u; }
  DEV const char* bbase(const Unit& u) const { return p.ws + OFF_WG + (size_t)u.pn * 256 * 2048; }
  DEV void epi(const acc_t& acc, const Unit& u, int wr, int wc, int fr, int fq) const {
    bf16_t* gates = WSP(bf16_t, OFF_GATES);
#pragma unroll
    for (int bj = 0; bj < 2; ++bj) {
      const int col = u.pn * 256 + wc * 64 + bj * 32 + 8 * fq;
      const f32x4 b0 = *(const f32x4*)(p.b_gate + col), b1 = *(const f32x4*)(p.b_gate + col + 4);
#pragma unroll
      for (int ai = 0; ai < 2; ++ai)
#pragma unroll
        for (int m = 0; m < 4; ++m) {
          const int row = u.pm * 256 + ai * 128 + wr * 64 + m * 16 + fr; f32x4 o0, o1;
#pragma unroll
          for (int e = 0; e < 4; ++e) { o0[e] = 1.0f / (1.0f + __expf(-(acc[ai][bj][m][0][e] + b0[e]))); o1[e] = 1.0f / (1.0f + __expf(-(acc[ai][bj][m][1][e] + b1[e]))); }
          __builtin_nontemporal_store(pk8(o0, o1), (u32x4*)(gates + (size_t)row * 3072 + col));
        }
    }
  }
};
template <int MODE> struct DGatesProbe {
  const Params& p; int K; StaticOrder S;
  DEV bool next(int i, Unit& u) const { return S.next(i, u.pm, u.pn); }
  DEV const char* abase(const Unit&) const { return (const char*)p.out; }
  DEV unsigned arow(const Unit& u, int r) const { return (unsigned)(u.pm * 256 + r) * 2048u; }
  DEV const char* bbase(const Unit& u) const { return p.ws + OFF_WG + (size_t)u.pn * 256 * 2048; }
  DEV void epi(const acc_t& acc, const Unit& u, int wr, int wc, int fr, int fq) const {
    bf16_t* dummy = WSP(bf16_t, OFF_IQ);
    if (MODE == 1) {
      float s = 0.f;
#pragma unroll
      for (int ai = 0; ai < 2; ++ai) for (int bj = 0; bj < 2; ++bj) for (int m = 0; m < 4; ++m) for (int n = 0; n < 2; ++n) s += acc[ai][bj][m][n][0] + acc[ai][bj][m][n][3];
      if (s == 12345.678f) dummy[0] = 1;
    } else {
#pragma unroll
      for (int bj = 0; bj < 2; ++bj) {
        const int col = wc * 64 + bj * 32 + 8 * fq;
#pragma unroll
        for (int ai = 0; ai < (MODE == 3 ? 1 : 2); ++ai)
#pragma unroll
          for (int m = 0; m < 4; ++m) { const int row = ai * 128 + wr * 64 + m * 16 + fr;
            *(u32x4*)(dummy + ((size_t)(u.pm & 15) * 256 + row) * 1024 + (u.pn & 3) * 256 + col) = pk8(acc[ai][bj][m][0] + acc[1][bj][m][0], acc[ai][bj][m][1] + acc[1][bj][m][1]); }
      }
    }
  }
};
struct DBranch {
  const Params& p; int K; StaticOrder S;
  DEV bool next(int i, Unit& u) const { u.aux = i % 3; return S.next(i / 3, u.pm, u.pn); }
  DEV const char* abase(const Unit& u) const { return u.aux == 0 ? p.ws + OFF_AQ : (u.aux == 1 ? (const char*)p.out + (size_t)64 * MiB : p.ws + OFF_MQ); }
  DEV unsigned arow(const Unit& u, int r) const { return (unsigned)(u.pm * 256 + r) * 1024u; }
  DEV const char* bbase(const Unit& u) const { return p.ws + OFF_WB + ((size_t)u.aux * 1024 + u.pn * 256) * 1024; }
  DEV void epi(const acc_t& acc, const Unit& u, int wr, int wc, int fr, int fq) const {
    const bf16_t* gates = WSP(bf16_t, OFF_GATES); bf16_t* merged = WSP(bf16_t, OFF_MERGED);
#pragma unroll
    for (int ai = 0; ai < 2; ++ai)
#pragma unroll
      for (int m = 0; m < 4; ++m) { const int row = u.pm * 256 + ai * 128 + wr * 64 + m * 16 + fr;
#pragma unroll
        for (int bj = 0; bj < 2; ++bj) {
          const int col = u.pn * 256 + wc * 64 + bj * 32 + 8 * fq;
          f32x4 g0, g1; unpk8(*(const u32x4*)(gates + (size_t)row * 3072 + u.aux * 1024 + col), g0, g1);
          f32x4 v0 = g0 * acc[ai][bj][m][0], v1 = g1 * acc[ai][bj][m][1];
          bf16_t* dst = merged + (size_t)row * 1024 + col;
          if (u.aux != 0) { f32x4 p0, p1; unpk8(*(const u32x4*)dst, p0, p1); v0 += p0; v1 += p1; }
          *(u32x4*)dst = pk8(v0, v1);
        } }
  }
};
struct DOut {
  const Params& p; int K; StaticOrder S;
  DEV bool next(int i, Unit& u) const { return S.next(i, u.pm, u.pn); }
  DEV const char* abase(const Unit&) const { return p.ws + OFF_MERGED; }
  DEV unsigned arow(const Unit& u, int r) const { return (unsigned)(u.pm * 256 + r) * 2048u; }
  DEV const char* bbase(const Unit& u) const { return p.ws + OFF_WO + (size_t)u.pn * 256 * 2048; }
  DEV void epi(const acc_t& acc, const Unit& u, int wr, int wc, int fr, int fq) const {
#pragma unroll
    for (int ai = 0; ai < 2; ++ai)
#pragma unroll
      for (int m = 0; m < 4; ++m) { const int row = u.pm * 256 + ai * 128 + wr * 64 + m * 16 + fr;
#pragma unroll
        for (int bj = 0; bj < 2; ++bj)
#pragma unroll
          for (int n = 0; n < 2; ++n) { const size_t o = (size_t)row * 1024 + u.pn * 256 + wc * 64 + bj * 32 + 8 * fq + 4 * n; *(f32x4*)(p.out + o) = *(const f32x4*)(p.x + o) + acc[ai][bj][m][n]; } }
  }
};
DEV bool moe_unit(const unsigned* cnt, int L, Unit& u) {
  int rt = L >> 2; u.pn = L & 3;
  for (int e = 0; e < 16; ++e) { const int ne = (int)cnt[e], te = (ne + 255) >> 8; if (rt < te) { u.pm = rt; u.aux = e; u.ne = ne; return true; } rt -= te; }
  return false;
}
struct DUp {
  const Params& p; int K;
  DEV bool next(int i, Unit& u) const { return moe_unit(WSP(unsigned, OFF_CNT), i * (int)gridDim.x + (int)blockIdx.x, u); }
  DEV const char* abase(const Unit&) const { return p.ws + OFF_HN; }
  DEV unsigned arow(const Unit& u, int r) const { const int rr = u.pm * 256 + r; return (unsigned)(WSP(int, OFF_LIST)[(size_t)u.aux * T + (rr < u.ne ? rr : u.ne - 1)] >> 1) * 2048u; }
  DEV const char* bbase(const Unit& u) const { return p.ws + OFF_W13 + ((size_t)u.aux * 1024 + u.pn * 256) * 2048; }
  DEV void epi(const acc_t& acc, const Unit& u, int wr, int wc, int fr, int fq) const {
    bf16_t* hid = WSP(bf16_t, OFF_HID); const int* le = WSP(int, OFF_LIST) + (size_t)u.aux * T; const float* cw = WSP(float, OFF_CW);
#pragma unroll
    for (int ai = 0; ai < 2; ++ai)
#pragma unroll
      for (int m = 0; m < 4; ++m) {
        const int rr = u.pm * 256 + ai * 128 + wr * 64 + m * 16 + fr;
        if (rr < u.ne) {
          const int ent = le[rr]; const float cwv = cw[ent]; f32x4 o[2];
#pragma unroll
          for (int n = 0; n < 2; ++n)
#pragma unroll
            for (int q = 0; q < 4; ++q) { const float v = acc[ai][0][m][n][q]; o[n][q] = v / (1.0f + __expf(-v)) * acc[ai][1][m][n][q] * cwv; }
          *(u32x4*)(hid + (size_t)ent * 512 + u.pn * 128 + wc * 32 + 8 * fq) = pk8(o[0], o[1]);
        }
      }
  }
};
struct DDown {
  const Params& p; int K;
  DEV bool next(int i, Unit& u) const { return moe_unit(WSP(unsigned, OFF_CNT), i * (int)gridDim.x + (int)blockIdx.x, u); }
  DEV const char* abase(const Unit&) const { return p.ws + OFF_HID; }
  DEV unsigned arow(const Unit& u, int r) const { const int rr = u.pm * 256 + r; return (unsigned)WSP(int, OFF_LIST)[(size_t)u.aux * T + (rr < u.ne ? rr : u.ne - 1)] * 1024u; }
  DEV const char* bbase(const Unit& u) const { return p.ws + OFF_W2 + ((size_t)u.aux * 1024 + u.pn * 256) * 1024; }
  DEV void epi(const acc_t& acc, const Unit& u, int wr, int wc, int fr, int fq) const {
    bf16_t* moe = WSP(bf16_t, OFF_MOE); const int* le = WSP(int, OFF_LIST) + (size_t)u.aux * T;
#pragma unroll
    for (int ai = 0; ai < 2; ++ai)
#pragma unroll
      for (int m = 0; m < 4; ++m) {
        const int rr = u.pm * 256 + ai * 128 + wr * 64 + m * 16 + fr;
        if (rr < u.ne) { const int ent = le[rr];
#pragma unroll
          for (int bj = 0; bj < 2; ++bj) *(u32x4*)(moe + (size_t)ent * 1024 + u.pn * 256 + wc * 64 + bj * 32 + 8 * fq) = pk8(acc[ai][bj][m][0], acc[ai][bj][m][1]); }
      }
  }
};
DEV void ph_gemm1(const Params& p, ldsb_t lds) {
  { DMemKV d{p, 1024}; gemm256(lds, d); }
  { DGemm1 d{p, 1024, {}}; d.S.init(T / 256, NIN_PAD / 256, gridDim.x, blockIdx.x); gemm256(lds, d); }
}
template <int MODE> DEV void ph_gates_probe(const Params& p, ldsb_t lds) { DGatesProbe<MODE> d{p, 1024, {}}; d.S.init(T / 256, 12, gridDim.x, blockIdx.x); gemm256(lds, d); }
DEV void ph_gates(const Params& p, ldsb_t lds) { DGates d{p, 1024, {}}; d.S.init(T / 256, 12, gridDim.x, blockIdx.x); gemm256(lds, d); }
DEV void ph_branch(const Params& p, ldsb_t lds) { DBranch d{p, 512, {}}; d.S.init(T / 256, 4, gridDim.x, blockIdx.x); gemm256(lds, d); }
DEV void ph_out(const Params& p, ldsb_t lds) { DOut d{p, 1024, {}}; d.S.init(T / 256, 4, gridDim.x, blockIdx.x); gemm256(lds, d); }
DEV void ph_up(const Params& p, ldsb_t lds) { DUp d{p, 1024}; gemm256(lds, d); }
DEV void ph_down(const Params& p, ldsb_t lds) { DDown d{p, 512}; gemm256(lds, d); }
typedef short v4i16_t __attribute__((ext_vector_type(4)));
template <int DH, int NKB, class KR, class VR, class MK>
DEV void attend16(const bf16_t* qrow, KR krow, VR vrow, MK mask, float sl2, char* vl, f32x4 (&o)[DH / 16], float& lse2) {
  static_assert(DH == 64 && NKB % 4 == 0, "gathered attention: head dim 64, key blocks in chunks of 4");
  const int lane = TIDX & 63, fr = lane & 15, fq = lane >> 4, lr = lane >> 3, lc = lane & 7;
  constexpr int KS = 2, STRIDE = 160, ND = 4, NPB = NKB / 2, VB = 4, NCH = NKB / 4;
  bf16x8 qf[KS];
#pragma unroll
  for (int s = 0; s < KS; ++s) qf[s] = *(const bf16x8*)(qrow + 32 * s + 8 * fq);
  f32x4 sc[NKB];
  char* kimg = vl; char* vimg = vl + 8192;
  const int kwoff = lr * 128 + (((lc ^ (lr >> 1)) & 7) << 4);
  const int swz = (fr >> 1) & 7;
  u32x4 kreg[2][8];
#pragma unroll
  for (int c = 0; c < 2; ++c)
#pragma unroll
    for (int i = 0; i < 8; ++i) kreg[c][i] = *(const u32x4*)(krow(c * 64 + 8 * i + lr) + lc * 8);
  u32x4 vreg[VB][4];
#pragma unroll
  for (int c = 0; c < NCH; ++c) {
#pragma unroll
    for (int i = 0; i < 8; ++i) { const int row = 8 * i + lr; *(u32x4*)(kimg + row * 128 + (((lc ^ (row >> 1)) & 7) << 4)) = kreg[c & 1][i]; }
    if (c + 2 < NCH) {
#pragma unroll
      for (int i = 0; i < 8; ++i) kreg[c & 1][i] = *(const u32x4*)(krow((c + 2) * 64 + 8 * i + lr) + lc * 8);
    }
    if (c == NCH - 1) {
#pragma unroll
      for (int j = 0; j < VB; ++j)
#pragma unroll
        for (int e = 0; e < 4; ++e) vreg[j][e] = *(const u32x4*)(vrow(j * 32 + 8 * e + lr) + lc * 8);
    }
#pragma unroll
    for (int kb = 0; kb < 4; ++kb) {
      f32x4 a = {0.f, 0.f, 0.f, 0.f};
#pragma unroll
      for (int s = 0; s < KS; ++s) { const bf16x8 kf = *(const bf16x8*)(kimg + (kb * 16 + fr) * 128 + (((4 * s + fq) ^ swz) << 4)); a = __builtin_amdgcn_mfma_f32_16x16x32_bf16(kf, qf[s], a, 0, 0, 0); }
      sc[4 * c + kb] = a;
    }
  }
  (void)kwoff;
  float mx = -INFINITY;
#pragma unroll
  for (int kb = 0; kb < NKB; ++kb)
#pragma unroll
    for (int i = 0; i < 4; ++i) { float v = sc[kb][i] * sl2; v = mask(kb * 16 + 4 * fq + i, fr) ? v : -INFINITY; sc[kb][i] = v; mx = fmaxf(mx, v); }
  mx = fmaxf(mx, __shfl_xor(mx, 16)); mx = fmaxf(mx, __shfl_xor(mx, 32));
  float l = 0.f;
#pragma unroll
  for (int kb = 0; kb < NKB; ++kb)
#pragma unroll
    for (int i = 0; i < 4; ++i) { const float pe = __builtin_amdgcn_exp2f(sc[kb][i] - mx); sc[kb][i] = pe; l += pe; }
  l += __shfl_xor(l, 16); l += __shfl_xor(l, 32);
#pragma unroll
  for (int db = 0; db < ND; ++db) o[db] = (f32x4){0.f, 0.f, 0.f, 0.f};
  typedef __attribute__((address_space(3))) v4i16_t* lds_v4p;
  const lds_v4p trb = (lds_v4p)(vimg + (4 * fq + (fr >> 2)) * STRIDE + (fr & 3) * 8);
#pragma unroll
  for (int pb0 = 0; pb0 < NPB; pb0 += VB) {
#pragma unroll
    for (int j = 0; j < VB; ++j) {
      const int pb = pb0 + j;
#pragma unroll
      for (int e = 0; e < 4; ++e) *(u32x4*)(vimg + (8 * e + lr) * STRIDE + lc * 16) = vreg[j][e];
      if (pb + VB < NPB) {
#pragma unroll
        for (int e = 0; e < 4; ++e) vreg[j][e] = *(const u32x4*)(vrow((pb + VB) * 32 + 8 * e + lr) + lc * 8);
      }
      u32x4 pw; pw.x = pk2(sc[2 * pb][0], sc[2 * pb][1]); pw.y = pk2(sc[2 * pb][2], sc[2 * pb][3]); pw.z = pk2(sc[2 * pb + 1][0], sc[2 * pb + 1][1]); pw.w = pk2(sc[2 * pb + 1][2], sc[2 * pb + 1][3]);
      const bf16x8 pf = __builtin_bit_cast(bf16x8, pw);
#pragma unroll
      for (int db = 0; db < ND; ++db) {
        const v4i16_t lo = __builtin_amdgcn_ds_read_tr16_b64_v4i16((lds_v4p)((__attribute__((address_space(3))) char*)trb + db * 32));
        const v4i16_t hi = __builtin_amdgcn_ds_read_tr16_b64_v4i16((lds_v4p)((__attribute__((address_space(3))) char*)trb + db * 32 + 16 * STRIDE));
        const bf16x8 vf = {lo[0], lo[1], lo[2], lo[3], hi[0], hi[1], hi[2], hi[3]};
        o[db] = __builtin_amdgcn_mfma_f32_16x16x32_bf16(vf, pf, o[db], 0, 0, 0);
      }
    }
  }
  const float inv = 1.0f / l;
#pragma unroll
  for (int db = 0; db < ND; ++db) o[db] *= inv;
  lse2 = mx + __builtin_amdgcn_logf(l);
}

template <int DH, int NKB, class MK>
DEV void attend16_sh(const bf16_t* qrow, const char* kt, const char* vt, MK mask, float sl2, f32x4 (&o)[DH / 16], float& lse2) {
  const int lane = TIDX & 63, fr = lane & 15, fq = lane >> 4;
  constexpr int KS = DH / 32, KST = DH * 2, VST = DH * 2 + 32, ND = DH / 16, NPB = (NKB + 1) / 2;
  bf16x8 qf[KS];
#pragma unroll
  for (int s = 0; s < KS; ++s) qf[s] = *(const bf16x8*)(qrow + 32 * s + 8 * fq);
  const int swz = DH == 64 ? ((fr >> 1) & 7) : fr;
  const char* kl = kt + fr * KST;
  f32x4 sc[2 * NPB];
#pragma unroll
  for (int kb = 0; kb < NKB; ++kb) {
    f32x4 a = {0.f, 0.f, 0.f, 0.f};
#pragma unroll
    for (int s = 0; s < KS; ++s) { const bf16x8 kf = *(const bf16x8*)(kl + kb * 16 * KST + (((4 * s + fq) ^ swz) << 4)); a = __builtin_amdgcn_mfma_f32_16x16x32_bf16(kf, qf[s], a, 0, 0, 0); }
    sc[kb] = a;
  }
  float mx = -INFINITY;
#pragma unroll
  for (int kb = 0; kb < NKB; ++kb)
#pragma unroll
    for (int i = 0; i < 4; ++i) { float v = sc[kb][i] * sl2; v = mask(kb * 16 + 4 * fq + i, fr) ? v : -INFINITY; sc[kb][i] = v; mx = fmaxf(mx, v); }
  mx = fmaxf(mx, __shfl_xor(mx, 16)); mx = fmaxf(mx, __shfl_xor(mx, 32));
  float l = 0.f;
#pragma unroll
  for (int kb = 0; kb < NKB; ++kb)
#pragma unroll
    for (int i = 0; i < 4; ++i) { const float pe = __builtin_amdgcn_exp2f(sc[kb][i] - mx); sc[kb][i] = pe; l += pe; }
  if (NKB & 1) sc[NKB] = (f32x4){0.f, 0.f, 0.f, 0.f};
  l += __shfl_xor(l, 16); l += __shfl_xor(l, 32);
#pragma unroll
  for (int db = 0; db < ND; ++db) o[db] = (f32x4){0.f, 0.f, 0.f, 0.f};
  typedef __attribute__((address_space(3))) v4i16_t* lds_v4p;
  typedef __attribute__((address_space(3))) char* lds_cp;
  const lds_cp trb = (lds_cp)(vt + (4 * fq + (fr >> 2)) * VST + (fr & 3) * 8);
#pragma unroll
  for (int pb = 0; pb < NPB; ++pb) {
    u32x4 pw; pw.x = pk2(sc[2 * pb][0], sc[2 * pb][1]); pw.y = pk2(sc[2 * pb][2], sc[2 * pb][3]); pw.z = pk2(sc[2 * pb + 1][0], sc[2 * pb + 1][1]); pw.w = pk2(sc[2 * pb + 1][2], sc[2 * pb + 1][3]);
    const bf16x8 pf = __builtin_bit_cast(bf16x8, pw);
#pragma unroll
    for (int db = 0; db < ND; ++db) {
      const v4i16_t lo = __builtin_amdgcn_ds_read_tr16_b64_v4i16((lds_v4p)(trb + pb * 32 * VST + db * 32));
      const v4i16_t hi = __builtin_amdgcn_ds_read_tr16_b64_v4i16((lds_v4p)(trb + pb * 32 * VST + db * 32 + 16 * VST));
      const bf16x8 vf = {lo[0], lo[1], lo[2], lo[3], hi[0], hi[1], hi[2], hi[3]};
      o[db] = __builtin_amdgcn_mfma_f32_16x16x32_bf16(vf, pf, o[db], 0, 0, 0);
    }
  }
  const float inv = 1.0f / l;
#pragma unroll
  for (int db = 0; db < ND; ++db) o[db] *= inv;
  lse2 = mx + __builtin_amdgcn_logf(l);
}
template <int DH, int NKB, class MK0, class MK1>
DEV void attend16_sh2(const bf16_t* q0, const bf16_t* q1, const char* kt0, const char* kt1, const char* vt0, const char* vt1, MK0 mask0, MK1 mask1, float sl2,
                      f32x4 (&o0)[DH / 16], f32x4 (&o1)[DH / 16], float& lse0, float& lse1) {
  const int lane = TIDX & 63, fr = lane & 15, fq = lane >> 4;
  constexpr int KS = DH / 32, KST = DH * 2, VST = DH * 2 + 32, ND = DH / 16, NPB = (NKB + 1) / 2;
  const bf16_t* qq[2] = {q0, q1}; const char* ktt[2] = {kt0, kt1}; const char* vtt[2] = {vt0, vt1};
  bf16x8 qf[2][KS];
#pragma unroll
  for (int t = 0; t < 2; ++t)
#pragma unroll
    for (int s = 0; s < KS; ++s) qf[t][s] = *(const bf16x8*)(qq[t] + 32 * s + 8 * fq);
  const int swz = DH == 64 ? ((fr >> 1) & 7) : fr;
  f32x4 sc[2][2 * NPB];
#pragma unroll
  for (int kb = 0; kb < NKB; ++kb)
#pragma unroll
    for (int t = 0; t < 2; ++t) {
      f32x4 a = {0.f, 0.f, 0.f, 0.f};
#pragma unroll
      for (int s = 0; s < KS; ++s) { const bf16x8 kf = *(const bf16x8*)(ktt[t] + fr * KST + kb * 16 * KST + (((4 * s + fq) ^ swz) << 4)); a = __builtin_amdgcn_mfma_f32_16x16x32_bf16(kf, qf[t][s], a, 0, 0, 0); }
      sc[t][kb] = a;
    }
  float mx[2] = {-INFINITY, -INFINITY};
#pragma unroll
  for (int kb = 0; kb < NKB; ++kb)
#pragma unroll
    for (int i = 0; i < 4; ++i) {
      float v0 = sc[0][kb][i] * sl2; v0 = mask0(kb * 16 + 4 * fq + i, fr) ? v0 : -INFINITY; sc[0][kb][i] = v0; mx[0] = fmaxf(mx[0], v0);
      float v1 = sc[1][kb][i] * sl2; v1 = mask1(kb * 16 + 4 * fq + i, fr) ? v1 : -INFINITY; sc[1][kb][i] = v1; mx[1] = fmaxf(mx[1], v1);
    }
#pragma unroll
  for (int t = 0; t < 2; ++t) { mx[t] = fmaxf(mx[t], __shfl_xor(mx[t], 16)); mx[t] = fmaxf(mx[t], __shfl_xor(mx[t], 32)); }
  float l[2] = {0.f, 0.f};
#pragma unroll
  for (int kb = 0; kb < NKB; ++kb)
#pragma unroll
    for (int i = 0; i < 4; ++i)
#pragma unroll
      for (int t = 0; t < 2; ++t) { const float pe = __builtin_amdgcn_exp2f(sc[t][kb][i] - mx[t]); sc[t][kb][i] = pe; l[t] += pe; }
  if (NKB & 1) { sc[0][NKB] = (f32x4){0.f, 0.f, 0.f, 0.f}; sc[1][NKB] = (f32x4){0.f, 0.f, 0.f, 0.f}; }
#pragma unroll
  for (int t = 0; t < 2; ++t) { l[t] += __shfl_xor(l[t], 16); l[t] += __shfl_xor(l[t], 32); }
#pragma unroll
  for (int db = 0; db < ND; ++db) { o0[db] = (f32x4){0.f, 0.f, 0.f, 0.f}; o1[db] = (f32x4){0.f, 0.f, 0.f, 0.f}; }
  typedef __attribute__((address_space(3))) v4i16_t* lds_v4p;
  typedef __attribute__((address_space(3))) char* lds_cp;
  const int troff = (4 * fq + (fr >> 2)) * VST + (fr & 3) * 8;
  const lds_cp trb0 = (lds_cp)(vtt[0] + troff), trb1 = (lds_cp)(vtt[1] + troff);
#pragma unroll
  for (int pb = 0; pb < NPB; ++pb) {
    u32x4 pw0, pw1;
    pw0.x = pk2(sc[0][2 * pb][0], sc[0][2 * pb][1]); pw0.y = pk2(sc[0][2 * pb][2], sc[0][2 * pb][3]); pw0.z = pk2(sc[0][2 * pb + 1][0], sc[0][2 * pb + 1][1]); pw0.w = pk2(sc[0][2 * pb + 1][2], sc[0][2 * pb + 1][3]);
    pw1.x = pk2(sc[1][2 * pb][0], sc[1][2 * pb][1]); pw1.y = pk2(sc[1][2 * pb][2], sc[1][2 * pb][3]); pw1.z = pk2(sc[1][2 * pb + 1][0], sc[1][2 * pb + 1][1]); pw1.w = pk2(sc[1][2 * pb + 1][2], sc[1][2 * pb + 1][3]);
    const bf16x8 pf0 = __builtin_bit_cast(bf16x8, pw0), pf1 = __builtin_bit_cast(bf16x8, pw1);
#pragma unroll
    for (int db = 0; db < ND; ++db) {
      const v4i16_t lo0 = __builtin_amdgcn_ds_read_tr16_b64_v4i16((lds_v4p)(trb0 + pb * 32 * VST + db * 32));
      const v4i16_t hi0 = __builtin_amdgcn_ds_read_tr16_b64_v4i16((lds_v4p)(trb0 + pb * 32 * VST + db * 32 + 16 * VST));
      const v4i16_t lo1 = __builtin_amdgcn_ds_read_tr16_b64_v4i16((lds_v4p)(trb1 + pb * 32 * VST + db * 32));
      const v4i16_t hi1 = __builtin_amdgcn_ds_read_tr16_b64_v4i16((lds_v4p)(trb1 + pb * 32 * VST + db * 32 + 16 * VST));
      const bf16x8 vf0 = {lo0[0], lo0[1], lo0[2], lo0[3], hi0[0], hi0[1], hi0[2], hi0[3]};
      const bf16x8 vf1 = {lo1[0], lo1[1], lo1[2], lo1[3], hi1[0], hi1[1], hi1[2], hi1[3]};
      o0[db] = __builtin_amdgcn_mfma_f32_16x16x32_bf16(vf0, pf0, o0[db], 0, 0, 0);
      o1[db] = __builtin_amdgcn_mfma_f32_16x16x32_bf16(vf1, pf1, o1[db], 0, 0, 0);
    }
  }
  const float inv0 = 1.0f / l[0], inv1 = 1.0f / l[1];
#pragma unroll
  for (int db = 0; db < ND; ++db) { o0[db] *= inv0; o1[db] *= inv1; }
  lse0 = mx[0] + __builtin_amdgcn_logf(l[0]); lse1 = mx[1] + __builtin_amdgcn_logf(l[1]);
}
constexpr float LOG2E = 1.4426950408889634f;
struct BUnit { int b, g, h, dsh, nsub, res, U0; };
DEV BUnit b_decode(int u) {
  BUnit r; const int x = u & 31, bgh = u >> 5; r.h = bgh & 7; const int bg = bgh >> 3; r.g = bg % 3; r.b = bg / 3;
  r.dsh = 2 * r.g; r.nsub = S >> r.dsh; const int cps = r.nsub >> 8; r.res = x / cps; r.U0 = (x % cps) * 256; return r;
}
constexpr int B_KROWS = 384, B_VROWS = 400, B_VOFF = B_KROWS * 128;
DEV void b_load(const Params& p, const BUnit& d, u32x4 (&kr)[6], u32x4 (&vr)[7]) {
  const int tid = TIDX;
  const size_t hoff = (size_t)(d.g * 8 + d.h) * 64;
  const bf16_t* kb_ = WSP(bf16_t, OFF_BK) + (size_t)d.b * S * 1536 + hoff;
  const bf16_t* vb_ = WSP(bf16_t, OFF_BV) + (size_t)d.b * S * 1536 + hoff;
#pragma unroll
  for (int i = 0; i < 6; ++i) { const int id = tid + NTH * i, row = id >> 3, ch = id & 7; int us = d.U0 - 128 + row; us = us < 0 ? 0 : (us >= d.nsub ? d.nsub - 1 : us);
    kr[i] = *(const u32x4*)(kb_ + (size_t)((us << d.dsh) + d.res) * 1536 + ch * 8); }
#pragma unroll
  for (int i = 0; i < 7; ++i) { int id = tid + NTH * i; id = id < B_VROWS * 8 ? id : B_VROWS * 8 - 1; const int row = id >> 3, ch = id & 7; int us = d.U0 - 128 + row; us = us < 0 ? 0 : (us >= d.nsub ? d.nsub - 1 : us);
    vr[i] = *(const u32x4*)(vb_ + (size_t)((us << d.dsh) + d.res) * 1536 + ch * 8); }
}
DEV void b_write(char* lds, const u32x4 (&kr)[6], const u32x4 (&vr)[7]) {
  const int tid = TIDX; char* kt = lds; char* vt = lds + B_VOFF;
#pragma unroll
  for (int i = 0; i < 6; ++i) { const int id = tid + NTH * i, row = id >> 3, ch = id & 7; *(u32x4*)(kt + row * 128 + (((ch ^ (row >> 1)) & 7) << 4)) = kr[i]; }
#pragma unroll
  for (int i = 0; i < 7; ++i) { const int id = tid + NTH * i; if (id < B_VROWS * 8) { const int row = id >> 3, ch = id & 7; *(u32x4*)(vt + row * 160 + ch * 16) = vr[i]; } }
}
DEV void b_compute(const Params& p, const BUnit& d, char* lds, bf16_t* dummy) {
  const int tid = TIDX, lane = tid & 63, wid = tid >> 6, fr = lane & 15, fq = lane >> 4;
  const size_t hoff = (size_t)(d.g * 8 + d.h) * 64;
  char* kt = lds; char* vt = lds + B_VOFF;
  const int uA = d.U0 + 16 * wid, uB = uA + 128;
  const int tqA = ((uA + fr) << d.dsh) + d.res, tqB = ((uB + fr) << d.dsh) + d.res;
  bf16_t* qA = WSP(bf16_t, OFF_BQ) + (size_t)(d.b * S + tqA) * 1536 + hoff;
  bf16_t* qB = WSP(bf16_t, OFF_BQ) + (size_t)(d.b * S + tqB) * 1536 + hoff;
  bf16_t* qoA = dummy ? dummy + ((qA - WSP(bf16_t, OFF_BQ)) & (8 * MiB - 1)) : qA;
  bf16_t* qoB = dummy ? dummy + ((qB - WSP(bf16_t, OFF_BQ)) & (8 * MiB - 1)) : qB;
  f32x4 oA[4], oB[4]; float lseA, lseB;
  attend16_sh2<64, 9>(qA, qB, kt + 16 * wid * 128, kt + 16 * (wid + 8) * 128, vt + 16 * wid * 160, vt + 16 * (wid + 8) * 160,
                      [&](int r, int c) { return r >= c && r <= 128 + c && (uA - 128 + r) >= 0; }, [&](int r, int c) { return r >= c && r <= 128 + c; }, 0.125f * LOG2E, oA, oB, lseA, lseB);
#pragma unroll
  for (int db = 0; db < 4; ++db) { *(u32x2*)(qoA + 16 * db + 4 * fq) = pk4(oA[db]); *(u32x2*)(qoB + 16 * db + 4 * fq) = pk4(oB[db]); }
  if (fq == 0 && !dummy) { float* lp = WSP(float, OFF_LSE) + d.g * 8 + d.h; lp[(size_t)(d.b * S + tqA) * 24] = lseA; lp[(size_t)(d.b * S + tqB) * 24] = lseB; }
}
DEV void ph_attn_b_blk(const Params& p, char* lds, bf16_t* dummy) {
  constexpr int NU = NB * 3 * 8 * 32;
  int u = blockIdx.x; if (u >= NU) return;
  u32x4 kr[6], vr[7];
  BUnit d = b_decode(u);
  b_load(p, d, kr, vr);
  for (;;) {
    b_write(lds, kr, vr);
    __syncthreads();
    const int un = u + gridDim.x; const bool more = un < NU;
    BUnit dn = d;
    if (more) { dn = b_decode(un); b_load(p, dn, kr, vr); }
    b_compute(p, d, lds, dummy);
    __syncthreads();
    if (!more) break;
    u = un; d = dn;
  }
}
DEV void unit_attn_m_blk(const Params& p, int u, char* lds, bf16_t* dummy = nullptr) {
  const int tid = TIDX, lane = tid & 63, wid = tid >> 6, fr = lane & 15, fq = lane >> 4;
  const int part = u & 15, h = (u >> 4) & 3, b = u >> 6;
  const bf16_t* kvb = WSP(bf16_t, OFF_KV) + (size_t)b * 256 * 1024 + h * 128;
  char* kt = lds; char* vt = lds + 65536;
#pragma unroll
  for (int hf = 0; hf < 2; ++hf) {
    u32x4 kr[4], vr[4];
#pragma unroll
    for (int i = 0; i < 4; ++i) { const int id = tid + NTH * (hf * 4 + i), row = id >> 4, ch = id & 15; kr[i] = *(const u32x4*)(kvb + (size_t)row * 1024 + ch * 8); vr[i] = *(const u32x4*)(kvb + (size_t)row * 1024 + 512 + ch * 8); }
#pragma unroll
    for (int i = 0; i < 4; ++i) { const int id = tid + NTH * (hf * 4 + i), row = id >> 4, ch = id & 15; *(u32x4*)(kt + row * 256 + (((ch ^ row) & 15) << 4)) = kr[i]; *(u32x4*)(vt + row * 288 + ch * 16) = vr[i]; }
  }
  __syncthreads();
#pragma unroll 1
  for (int tl = wid; tl < 32; tl += NWV) {
    const int t0 = b * S + part * 512 + tl * 16;
    bf16_t* q = WSP(bf16_t, OFF_MQ) + (size_t)(t0 + fr) * 512 + h * 128;
    bf16_t* qo = dummy ? dummy + ((q - WSP(bf16_t, OFF_MQ)) & (8 * MiB - 1)) : q;
    f32x4 o[8]; float lse;
    attend16_sh<128, 16>(q, kt, vt, [&](int, int) { return true; }, 0.08838834764831845f * LOG2E, o, lse);
#pragma unroll
    for (int db = 0; db < 8; ++db) *(u32x2*)(qo + 16 * db + 4 * fq) = pk4(o[db]);
  }
  __syncthreads();
}
DEV void ph_attn_blk(const Params& p, char* lds, bf16_t* dummy = nullptr) {
  ph_attn_b_blk(p, lds, dummy);
  for (int u = blockIdx.x; u < NB * 4 * 16; u += gridDim.x) unit_attn_m_blk(p, u, lds, dummy);
}

DEV void unit_attn_a4(const Params& p, int u, char* vl, bf16_t* dummy = nullptr) {
  const int lane = TIDX & 63, fr = lane & 15, fq = lane >> 4, lr = lane >> 3, lc = lane & 7;
  const int kvh = u & 1, row0 = (u >> 1) * 4, b = row0 / S, t0 = row0 % S;
  const int myt = fr >> 2;
  const int cntc = (t0 + myt + 1) < 256 ? (t0 + myt + 1) : 256;
  bf16_t* q = WSP(bf16_t, OFF_AQ) + (size_t)(row0 + myt) * 512 + (kvh * 4 + (fr & 3)) * 64;
  unsigned short* sl = (unsigned short*)(vl + 13312);
#pragma unroll
  for (int ti = 0; ti < 4; ++ti) {
    const int cnt = (t0 + ti + 1) < 256 ? (t0 + ti + 1) : 256;
    u32x2 sv = *(const u32x2*)(WSP(unsigned short, OFF_SEL) + (size_t)(row0 + ti) * 256 + lane * 4);
    const int k0 = lane * 4;
    sv.x = (k0 < cnt ? sv.x & 0xFFFFu : 0u) | (k0 + 1 < cnt ? sv.x & 0xFFFF0000u : 0u);
    sv.y = (k0 + 2 < cnt ? sv.y & 0xFFFFu : 0u) | (k0 + 3 < cnt ? sv.y & 0xFFFF0000u : 0u);
    *(u32x2*)(vl + 13312 + ti * 512 + lane * 8) = sv;
  }
  const bf16_t* kb_ = WSP(bf16_t, OFF_AK) + (size_t)b * S * 128 + kvh * 64;
  const bf16_t* vb_ = WSP(bf16_t, OFF_AV) + (size_t)b * S * 128 + kvh * 64;
  bf16_t* qo = dummy ? dummy + ((q - WSP(bf16_t, OFF_AQ)) & (8 * MiB - 1)) : q;
  constexpr int NKB = 16, STRIDE = 160;
  bf16x8 qf[2];
#pragma unroll
  for (int s = 0; s < 2; ++s) qf[s] = *(const bf16x8*)(q + 32 * s + 8 * fq);
  char* kimg = vl; char* vimg = vl + 8192;
  const int swz = (fr >> 1) & 7;
  f32x4 sc[NKB];
#pragma unroll
  for (int kb = 0; kb < NKB; ++kb) sc[kb] = (f32x4){0.f, 0.f, 0.f, 0.f};
  u32x4 kreg[2][8];
#pragma unroll
  for (int c = 0; c < 2; ++c)
#pragma unroll
    for (int i = 0; i < 8; ++i) kreg[c][i] = *(const u32x4*)(kb_ + (size_t)sl[c * 64 + 8 * i + lr] * 128 + lc * 8);
#pragma unroll
  for (int cc = 0; cc < 16; ++cc) {
    const int ti = cc >> 2, c = cc & 3;
#pragma unroll
    for (int i = 0; i < 8; ++i) { const int row = 8 * i + lr; *(u32x4*)(kimg + row * 128 + (((lc ^ (row >> 1)) & 7) << 4)) = kreg[cc & 1][i]; }
    if (cc + 2 < 16) {
      const int t2 = (cc + 2) >> 2, c2 = (cc + 2) & 3;
#pragma unroll
      for (int i = 0; i < 8; ++i) kreg[cc & 1][i] = *(const u32x4*)(kb_ + (size_t)sl[t2 * 256 + c2 * 64 + 8 * i + lr] * 128 + lc * 8);
    }
#pragma unroll
    for (int kb = 0; kb < 4; ++kb) {
      f32x4 a = {0.f, 0.f, 0.f, 0.f};
#pragma unroll
      for (int s = 0; s < 2; ++s) { const bf16x8 kf = *(const bf16x8*)(kimg + (kb * 16 + fr) * 128 + (((4 * s + fq) ^ swz) << 4)); a = __builtin_amdgcn_mfma_f32_16x16x32_bf16(kf, qf[s], a, 0, 0, 0); }
      sc[4 * c + kb] = (myt == ti) ? a : sc[4 * c + kb];
    }
  }
  const float sl2 = 0.125f * LOG2E;
  float mx = -INFINITY;
#pragma unroll
  for (int kb = 0; kb < NKB; ++kb)
#pragma unroll
    for (int i = 0; i < 4; ++i) { float v = sc[kb][i] * sl2; v = (kb * 16 + 4 * fq + i) < cntc ? v : -INFINITY; sc[kb][i] = v; mx = fmaxf(mx, v); }
  mx = fmaxf(mx, __shfl_xor(mx, 16)); mx = fmaxf(mx, __shfl_xor(mx, 32));
  float l = 0.f;
#pragma unroll
  for (int kb = 0; kb < NKB; ++kb)
#pragma unroll
    for (int i = 0; i < 4; ++i) { const float pe = __builtin_amdgcn_exp2f(sc[kb][i] - mx); sc[kb][i] = pe; l += pe; }
  l += __shfl_xor(l, 16); l += __shfl_xor(l, 32);
  const float inv = 1.0f / l;
  bf16x8 pf[8];
#pragma unroll
  for (int pb = 0; pb < 8; ++pb) { u32x4 pw; pw.x = pk2(sc[2 * pb][0], sc[2 * pb][1]); pw.y = pk2(sc[2 * pb][2], sc[2 * pb][3]); pw.z = pk2(sc[2 * pb + 1][0], sc[2 * pb + 1][1]); pw.w = pk2(sc[2 * pb + 1][2], sc[2 * pb + 1][3]);
    pf[pb] = __builtin_bit_cast(bf16x8, pw); }
  typedef __attribute__((address_space(3))) v4i16_t* lds_v4p;
  const lds_v4p trb = (lds_v4p)(vimg + (4 * fq + (fr >> 2)) * STRIDE + (fr & 3) * 8);
  u32x4 vreg[4][4];
#pragma unroll
  for (int j = 0; j < 4; ++j)
#pragma unroll
    for (int e = 0; e < 4; ++e) vreg[j][e] = *(const u32x4*)(vb_ + (size_t)sl[j * 32 + 8 * e + lr] * 128 + lc * 8);
  f32x4 o[4];
#pragma unroll
  for (int pp = 0; pp < 32; ++pp) {
    const int ti = pp >> 3, pb = pp & 7;
    if (pb == 0) {
#pragma unroll
      for (int db = 0; db < 4; ++db) o[db] = (f32x4){0.f, 0.f, 0.f, 0.f};
    }
#pragma unroll
    for (int e = 0; e < 4; ++e) *(u32x4*)(vimg + (8 * e + lr) * STRIDE + lc * 16) = vreg[pp & 3][e];
    if (pp + 4 < 32) {
      const int t2 = (pp + 4) >> 3, p2 = (pp + 4) & 7;
#pragma unroll
      for (int e = 0; e < 4; ++e) vreg[pp & 3][e] = *(const u32x4*)(vb_ + (size_t)sl[t2 * 256 + p2 * 32 + 8 * e + lr] * 128 + lc * 8);
    }
#pragma unroll
    for (int db = 0; db < 4; ++db) {
      const v4i16_t lo = __builtin_amdgcn_ds_read_tr16_b64_v4i16((lds_v4p)((__attribute__((address_space(3))) char*)trb + db * 32));
      const v4i16_t hi = __builtin_amdgcn_ds_read_tr16_b64_v4i16((lds_v4p)((__attribute__((address_space(3))) char*)trb + db * 32 + 16 * STRIDE));
      const bf16x8 vf = {lo[0], lo[1], lo[2], lo[3], hi[0], hi[1], hi[2], hi[3]};
      o[db] = __builtin_amdgcn_mfma_f32_16x16x32_bf16(vf, pf[pb], o[db], 0, 0, 0);
    }
    if (pb == 7 && myt == ti) {
#pragma unroll
      for (int db = 0; db < 4; ++db) *(u32x2*)(qo + 16 * db + 4 * fq) = pk4(o[db] * inv);
    }
  }
}
DEV void ph_mergeb(const Params& p) {
  const bf16_t* og = WSP(bf16_t, OFF_BQ); const float* lse = WSP(float, OFF_LSE); bf16_t* yb = ((bf16_t*)p.out + (size_t)32 * MiB);
  for (int it = blockIdx.x * NTH + TIDX; it < T * 64; it += gridDim.x * NTH) {
    const int ch = it & 7, h = (it >> 3) & 7, row = it >> 6;
    const float l0 = lse[(size_t)row * 24 + h], l1 = lse[(size_t)row * 24 + 8 + h], l2 = lse[(size_t)row * 24 + 16 + h];
    const float mx = fmaxf(l0, fmaxf(l1, l2));
    float a0 = __builtin_amdgcn_exp2f(l0 - mx), a1 = __builtin_amdgcn_exp2f(l1 - mx), a2 = __builtin_amdgcn_exp2f(l2 - mx);
    const float inv = 1.0f / (a0 + a1 + a2); a0 *= inv; a1 *= inv; a2 *= inv;
    const bf16_t* src = og + (size_t)row * 1536 + h * 64 + ch * 8;
    const u32x4 v0 = *(const u32x4*)src, v1 = *(const u32x4*)(src + 512), v2 = *(const u32x4*)(src + 1024);
    u32x4 r;
#pragma unroll
    for (int e = 0; e < 4; ++e) {
      const float lo = a0 * __uint_as_float(v0[e] << 16) + a1 * __uint_as_float(v1[e] << 16) + a2 * __uint_as_float(v2[e] << 16);
      const float hi = a0 * __uint_as_float(v0[e] & 0xFFFF0000u) + a1 * __uint_as_float(v1[e] & 0xFFFF0000u) + a2 * __uint_as_float(v2[e] & 0xFFFF0000u);
      r[e] = pk2(lo, hi);
    }
    *(u32x4*)(yb + (size_t)row * 512 + h * 64 + ch * 8) = r;
  }
}

DEV float key2f(unsigned key) { return __uint_as_float((key & 0x80000000u) ? (key & 0x7FFFFFFFu) : ~key); }
typedef _Float16 h2_t __attribute__((ext_vector_type(2)));
typedef __fp16 hh2_t __attribute__((ext_vector_type(2)));
typedef _Float16 h8_t __attribute__((ext_vector_type(8)));
DEV unsigned pkrelu(float a, float b) {
  const hh2_t r = __builtin_amdgcn_cvt_pkrtz(a, b); h2_t v = __builtin_bit_cast(h2_t, r);
  const h2_t z = {(_Float16)0, (_Float16)0}; v = __builtin_elementwise_max(v, z); return __builtin_bit_cast(unsigned, v);
}
template <int PASS>
DEV void topk_pass(const bf16_t* ikb, unsigned short* selb, int t0, int qt, const bf16x8 (&af)[8][2], const h8_t (&wop)[2][2], unsigned* hist, int* st,
                   const float (&flo)[2], const float (&fhi)[2], const int (&exc)[2], const int (&loff)[2]) {
  const int lane = TIDX & 63, wid = TIDX >> 6, kx = lane & 15, q4 = lane >> 4;
  const int nslab = 2 * qt + 2;
  auto process = [&](int slab, const bf16x8& kf0, const bf16x8& kf1) {
    const bool diag = slab >= 2 * qt;
    f32x4 a[8];
#pragma unroll
    for (int mt = 0; mt < 8; ++mt) {
      a[mt] = (f32x4){0.f, 0.f, 0.f, 0.f};
      a[mt] = __builtin_amdgcn_mfma_f32_16x16x32_bf16(af[mt][0], kf0, a[mt], 0, 0, 0);
    }
#pragma unroll
    for (int mt = 0; mt < 8; ++mt) a[mt] = __builtin_amdgcn_mfma_f32_16x16x32_bf16(af[mt][1], kf1, a[mt], 0, 0, 0);
    f32x4 c2[2];
#pragma unroll
    for (int g2 = 0; g2 < 2; ++g2) {
      c2[g2] = (f32x4){0.f, 0.f, 0.f, 0.f};
#pragma unroll
      for (int pp = 0; pp < 2; ++pp) {
        const int m0 = 4 * g2 + 2 * pp;
        u32x4 pw; pw.x = pkrelu(a[m0][0], a[m0][1]); pw.y = pkrelu(a[m0][2], a[m0][3]); pw.z = pkrelu(a[m0 + 1][0], a[m0 + 1][1]); pw.w = pkrelu(a[m0 + 1][2], a[m0 + 1][3]);
        c2[g2] = __builtin_amdgcn_mfma_f32_16x16x32_f16(__builtin_bit_cast(h8_t, pw), wop[g2][pp], c2[g2], 0, 0, 0);
      }
    }
    const int key0 = slab * 16 + 4 * q4;
#pragma unroll
    for (int g2 = 0; g2 < 2; ++g2) {
      const int row = 16 * g2 + kx;
      float sc[4];
#pragma unroll
      for (int i = 0; i < 4; ++i) sc[i] = (diag && key0 + i > t0 + row) ? -INFINITY : c2[g2][i] + 0.0f;
      if (PASS == 0) {
#pragma unroll
        for (int i = 0; i < 4; ++i) { const unsigned u = __float_as_uint(sc[i]); atomicAdd(&hist[row * 512 + (u >> 23)], 1u << ((u >> 18) & 16u)); }
      } else if (PASS == 1) {
#pragma unroll
        for (int i = 0; i < 4; ++i)
          if (sc[i] >= flo[g2] && sc[i] < fhi[g2]) {
            const unsigned u = __float_as_uint(sc[i]);
            const unsigned fine = ((u ^ ((unsigned)((int)u >> 31) | 0x80000000u)) >> 12) & 1023u;
            atomicAdd(&hist[row * 512 + (fine >> 1)], 1u << ((fine & 1u) * 16));
          }
      } else if (PASS == 2) {
        int pos[4];
#pragma unroll
        for (int i = 0; i < 4; ++i) {
          const bool above = sc[i] >= fhi[g2], tie = !above && sc[i] >= flo[g2];
          pos[i] = -1;
          if (above || (tie && !exc[g2])) pos[i] = atomicAdd(&st[192 + row], 1);
          else if (tie) atomicOr(&hist[row * 256 + ((key0 + i) >> 5)], 1u << ((key0 + i) & 31));
        }
#pragma unroll
        for (int i = 0; i < 4; ++i) if (pos[i] >= 0) selb[(size_t)(t0 + row) * 256 + pos[i]] = (unsigned short)(key0 + i);
      } else {
        int pos[4];
#pragma unroll
        for (int i = 0; i < 4; ++i) {
          pos[i] = -1;
          if (sc[i] >= fhi[g2]) pos[i] = atomicAdd(&st[192 + row], 1);
          else if (sc[i] >= flo[g2]) {
            const unsigned u = __float_as_uint(sc[i]);
            const unsigned fine = ((u ^ ((unsigned)((int)u >> 31) | 0x80000000u)) >> 12) & 1023u;
            atomicAdd(&hist[row * 512 + (fine >> 1)], 1u << ((fine & 1u) * 16));
            const int lp = atomicAdd(&st[224 + row], 1);
            hist[16384 + loff[g2] + lp] = (fine << 13) | (unsigned)(key0 + i);
          }
        }
#pragma unroll
        for (int i = 0; i < 4; ++i) if (pos[i] >= 0) selb[(size_t)(t0 + row) * 256 + pos[i]] = (unsigned short)(key0 + i);
      }
    }
  };
  const bf16_t* kbase = ikb + (size_t)kx * 64 + 16 * q4;
  bf16x8 kq0[4], kq1[4];
#pragma unroll
  for (int j = 0; j < 4; ++j) { int s2 = wid + j * NWV; s2 = s2 < nslab ? s2 : wid; const bf16_t* kp = kbase + (size_t)s2 * 1024; kq0[j] = *(const bf16x8*)kp; kq1[j] = *(const bf16x8*)(kp + 8); }
  for (int slab = wid; slab < nslab; slab += 4 * NWV) {
#pragma unroll
    for (int j = 0; j < 4; ++j) {
      const int sj = slab + j * NWV;
      if (sj < nslab) process(sj, kq0[j], kq1[j]);
      int s2 = sj + 4 * NWV; s2 = s2 < nslab ? s2 : wid; const bf16_t* kp = kbase + (size_t)s2 * 1024; kq0[j] = *(const bf16x8*)kp; kq1[j] = *(const bf16x8*)(kp + 8);
    }
  }
}
DEV void topk_scan(unsigned* hist, int* st, int level) {
  const int lane = TIDX & 63, wid = TIDX >> 6;
  for (int i = 0; i < 4; ++i) {
    const int row = wid * 4 + i;
    const int k = level == 0 ? st[row] : st[64 + row];
    const bool rev = level == 0 && lane < 32;
    const int wbase = level == 0 ? (lane >= 32 ? lane * 8 - 256 : 504 - lane * 8) : lane * 8;
    const u32x4 w0 = *(const u32x4*)(hist + row * 512 + wbase), w1 = *(const u32x4*)(hist + row * 512 + wbase + 4);
    int c[16];
#pragma unroll
    for (int j = 0; j < 4; ++j) { c[2 * j] = (int)(w0[j] & 0xFFFFu); c[2 * j + 1] = (int)(w0[j] >> 16); c[8 + 2 * j] = (int)(w1[j] & 0xFFFFu); c[9 + 2 * j] = (int)(w1[j] >> 16); }
    if (rev) {
#pragma unroll
      for (int j = 0; j < 8; ++j) { const int t = c[j]; c[j] = c[15 - j]; c[15 - j] = t; }
    }
    int tot = 0;
#pragma unroll
    for (int j = 0; j < 16; ++j) tot += c[j];
    int v = tot;
#pragma unroll
    for (int off = 1; off < 64; off <<= 1) { const int t = __shfl_down(v, off); if (lane + off < 64) v += t; }
    const int excl = v - tot;
    if (excl < k && k <= v) {
      int cum = excl, bsel = 0, rsel = 0, csel = 0; bool found = false;
#pragma unroll
      for (int j = 15; j >= 0; --j) { if (!found && cum + c[j] >= k) { bsel = lane * 16 + j; rsel = k - cum; csel = c[j]; found = true; } cum += c[j]; }
      if (level == 0) { st[32 + row] = bsel; st[64 + row] = rsel; st[288 + row] = csel; }
      else { st[96 + row] = (st[32 + row] << 10) | bsel; st[128 + row] = csel > rsel ? 1 : 0; st[160 + row] = rsel; }
    }
  }
}
DEV void topk_unit(const Params& p, int b, int qt, char* lds) {
  const int tid = TIDX, lane = tid & 63, wid = tid >> 6, kx = lane & 15, q4 = lane >> 4;
  const int t0 = qt * 32; const size_t rb = (size_t)b * S;
  unsigned* hist = (unsigned*)lds; int* st = (int*)(lds + 131072);
  const bf16_t* iq = WSP(bf16_t, OFF_IQ); const bf16_t* ikb = WSP(bf16_t, OFF_IK) + rb * 64; const float* iw = WSP(float, OFF_IW);
  unsigned short* selb = WSP(unsigned short, OFF_SEL) + rb * 256;
  bf16x8 af[8][2];
#pragma unroll
  for (int mt = 0; mt < 8; ++mt) {
    const bf16_t* ap = iq + ((rb + t0 + 4 * mt + (kx >> 2)) * 4 + (kx & 3)) * 64 + 16 * q4;
    af[mt][0] = *(const bf16x8*)ap; af[mt][1] = *(const bf16x8*)(ap + 8);
  }
  h8_t wop[2][2];
#pragma unroll
  for (int g2 = 0; g2 < 2; ++g2) {
    const f32x4 w = *(const f32x4*)(iw + (rb + t0 + 16 * g2 + kx) * 4);
    const hh2_t w01 = __builtin_amdgcn_cvt_pkrtz(w[0], w[1]), w23 = __builtin_amdgcn_cvt_pkrtz(w[2], w[3]);
    const unsigned u01 = __builtin_bit_cast(unsigned, w01), u23 = __builtin_bit_cast(unsigned, w23);
    const bool mine = (kx & 3) == q4;
#pragma unroll
    for (int pp = 0; pp < 2; ++pp) {
      const bool inpair = mine && ((kx >> 3) == pp); const bool hi = (kx >> 2) & 1;
      u32x4 o; o.x = (inpair && !hi) ? u01 : 0u; o.y = (inpair && !hi) ? u23 : 0u; o.z = (inpair && hi) ? u01 : 0u; o.w = (inpair && hi) ? u23 : 0u;
      wop[g2][pp] = __builtin_bit_cast(h8_t, o);
    }
  }
  const u32x4 z4 = {0u, 0u, 0u, 0u};
#pragma unroll
  for (int i = 0; i < 8; ++i) *(u32x4*)(lds + (i * NTH + tid) * 16) = z4;
  if (tid < 32) { const int n = t0 + tid + 1; st[tid] = n < 256 ? n : 256; st[192 + tid] = 0; st[224 + tid] = 0; }
  if (tid == 32) st[256] = 0;
  __syncthreads();
  float flo[2] = {0.f, 0.f}, fhi[2] = {0.f, 0.f}; int exc[2] = {0, 0}, loff[2] = {0, 0};
  topk_pass<0>(ikb, selb, t0, qt, af, wop, hist, st, flo, fhi, exc, loff);
  __syncthreads();
  topk_scan(hist, st, 0);
  __syncthreads();
  if (tid < 64) {
    const int c0 = tid < 32 ? st[288 + tid] : 0; int v = c0;
#pragma unroll
    for (int off = 1; off < 32; off <<= 1) { const int t = __shfl_up(v, off); if (lane >= off) v += t; }
    if (tid < 32) st[320 + tid] = v - c0;
    if (tid == 31) st[256] = v > 16384 ? 1 : 0;
  }
  __syncthreads();
  const bool fallback = st[256] != 0;
#pragma unroll
  for (int i = 0; i < 8; ++i) *(u32x4*)(lds + (i * NTH + tid) * 16) = z4;
#pragma unroll
  for (int g2 = 0; g2 < 2; ++g2) { loff[g2] = st[320 + 16 * g2 + kx]; const unsigned b0 = (unsigned)st[32 + 16 * g2 + kx]; flo[g2] = key2f(b0 << 22); fhi[g2] = b0 >= 1023u ? INFINITY : key2f((b0 + 1u) << 22); }
  __syncthreads();
  if (!fallback) {
    topk_pass<3>(ikb, selb, t0, qt, af, wop, hist, st, flo, fhi, exc, loff);
    __syncthreads();
    topk_scan(hist, st, 1);
    __syncthreads();
#pragma unroll
    for (int i = 0; i < 4; ++i) *(u32x4*)(lds + (i * NTH + tid) * 16) = z4;
    __syncthreads();
    for (int i = 0; i < 4; ++i) {
      const int row = wid * 4 + i, n = st[224 + row], b1 = st[96 + row] & 1023, ex = st[128 + row];
      for (int e = lane; e < n; e += 64) {
        const unsigned w = hist[16384 + st[320 + row] + e]; const int fine = (int)(w >> 13), key = (int)(w & 8191u);
        if (fine > b1 || (fine == b1 && !ex)) { const int pos = atomicAdd(&st[192 + row], 1); selb[(size_t)(t0 + row) * 256 + pos] = (unsigned short)key; }
        else if (fine == b1) atomicOr(&hist[row * 256 + (key >> 5)], 1u << (key & 31));
      }
    }
  } else {
    topk_pass<1>(ikb, selb, t0, qt, af, wop, hist, st, flo, fhi, exc, loff);
    __syncthreads();
    topk_scan(hist, st, 1);
    __syncthreads();
#pragma unroll
    for (int i = 0; i < 4; ++i) *(u32x4*)(lds + (i * NTH + tid) * 16) = z4;
#pragma unroll
    for (int g2 = 0; g2 < 2; ++g2) { const unsigned T20 = (unsigned)st[96 + 16 * g2 + kx]; flo[g2] = key2f(T20 << 12); fhi[g2] = T20 >= 0xFFFFFu ? INFINITY : key2f((T20 + 1u) << 12); exc[g2] = st[128 + 16 * g2 + kx]; }
    __syncthreads();
    topk_pass<2>(ikb, selb, t0, qt, af, wop, hist, st, flo, fhi, exc, loff);
  }
  __syncthreads();
  for (int i = 0; i < 4; ++i) {
    const int row = wid * 4 + i;
    if (st[128 + row]) {
      const int r1 = st[160 + row], base = st[row] - r1;
      const u32x4 w = *(const u32x4*)(hist + row * 256 + lane * 4);
      const int pc = __popc(w.x) + __popc(w.y) + __popc(w.z) + __popc(w.w);
      int v = pc;
#pragma unroll
      for (int off = 1; off < 64; off <<= 1) { const int t = __shfl_up(v, off); if (lane >= off) v += t; }
      int rank = v - pc;
#pragma unroll
      for (int j = 0; j < 4; ++j) { unsigned ww = w[j];
        while (ww && rank < r1) { const int bit = __ffs((int)ww) - 1; selb[(size_t)(t0 + row) * 256 + base + rank] = (unsigned short)((lane * 4 + j) * 32 + bit); ++rank; ww &= ww - 1u; } }
    }
  }
  __syncthreads();
}
DEV void ph_topk(const Params& p, char* lds) {
  for (int i = blockIdx.x; i < 512; i += gridDim.x) {
    topk_unit(p, i & 3, i >> 2, lds);
    const int j = 1023 - i;
    topk_unit(p, j & 3, j >> 2, lds);
  }
}


#define XB_TMO      128
#define XB_XCNT(j)  (256  + 64 * (j))
#define XB_XSUB(j)  (1280 + 64 * (j))
#define XB_XGEN(j)  (2304 + 64 * (j))
#define XB_TOP      3328
#define XB_TOPGEN   3392
#define XCD_BAR_WORDS 3456
#define XB_SPIN_CAP (1u << 18)
#define LAS __attribute__((address_space(3)))
__device__ __forceinline__ unsigned xb_ld(unsigned* p)              { return __hip_atomic_load(p, __ATOMIC_RELAXED, __HIP_MEMORY_SCOPE_AGENT); }
__device__ __forceinline__ unsigned xb_add(unsigned* p, unsigned v) { return __hip_atomic_fetch_add(p, v, __ATOMIC_RELAXED, __HIP_MEMORY_SCOPE_AGENT); }
__device__ __forceinline__ unsigned xb_xcc_id() { return (unsigned)__builtin_amdgcn_s_getreg((3 << 11) | 20) & 0xFu; }
#define XB_SPIN(cond, bar) do { unsigned _sp = 0; while (cond) { __builtin_amdgcn_s_sleep(1); \
    if ((++_sp & 255u) == 0u) { if (xb_ld(&(bar)[XB_TMO])) break; if (_sp > XB_SPIN_CAP) { atomicAdd(&(bar)[XB_TMO], 1u); break; } } } } while (0)
struct XcdBarrier { unsigned* bar; unsigned x; volatile LAS unsigned* st; };
__device__ __forceinline__ XcdBarrier xcd_barrier_post(unsigned* bar, volatile LAS unsigned* st) {
    XcdBarrier b; b.bar = bar; b.x = xb_xcc_id(); b.st = st;
    if (threadIdx.x == 0) (void)xb_add(&bar[XB_XCNT(b.x)], 1u);
    return b;
}
__device__ __forceinline__ void xcd_barrier_complete(unsigned* bar, unsigned x, unsigned& nloc, unsigned& nx) {
    const unsigned G = gridDim.x * gridDim.y * gridDim.z;
    unsigned sum, cnt, mine, sp = 0u;
    for (;;) {
        sum = 0u; cnt = 0u; mine = 0u;
#pragma unroll
        for (unsigned j = 0; j < 16; ++j) { const unsigned c = xb_ld(&bar[XB_XCNT(j)]); sum += c; cnt += (c > 0u) ? 1u : 0u; mine = (j == x) ? c : mine; }
        if (sum == G) break;
        __builtin_amdgcn_s_sleep(1);
        if ((++sp & 255u) == 0u) { if (xb_ld(&bar[XB_TMO])) break; if (sp > XB_SPIN_CAP) { atomicAdd(&bar[XB_TMO], 1u); break; } }
    }
    nloc = mine > 0u ? mine : 1u; nx = cnt > 0u ? cnt : 1u;
}
__device__ __forceinline__ void xcd_barrier(const XcdBarrier& b) {
    asm volatile("s_waitcnt vmcnt(0)" ::: "memory");
    __syncthreads();
    if (threadIdx.x == 0) {
        unsigned* bar = b.bar;
        __builtin_amdgcn_s_waitcnt(0);
        unsigned nloc = b.st[0], nx = b.st[1];
        if (nloc == 0u) { xcd_barrier_complete(bar, b.x, nloc, nx); b.st[0] = nloc; b.st[1] = nx; }
        const unsigned old = xb_add(&bar[XB_XSUB(b.x)], 1u);
        const unsigned gen = old / nloc;
        if (old + 1u == (gen + 1u) * nloc) {
            __builtin_amdgcn_fence(__ATOMIC_RELEASE, "agent");
            asm volatile("s_waitcnt vmcnt(0)" ::: "memory");
            const unsigned og = xb_add(&bar[XB_TOP], 1u);
            const unsigned tg = og / nx;
            if (og + 1u == (tg + 1u) * nx) xb_add(&bar[XB_TOPGEN], 1u);
            else XB_SPIN(xb_ld(&bar[XB_TOPGEN]) == tg, bar);
            __builtin_amdgcn_fence(__ATOMIC_ACQUIRE, "agent");
            xb_add(&bar[XB_XGEN(b.x)], 1u);
            asm volatile("s_waitcnt vmcnt(0)" ::: "memory");
        } else {
            XB_SPIN(xb_ld(&bar[XB_XGEN(b.x)]) == gen, bar);
            __builtin_amdgcn_fence(__ATOMIC_ACQUIRE, "agent");
            asm volatile("s_waitcnt vmcnt(0)" ::: "memory");
        }
    }
    __syncthreads();
}

DEV void ph_route(const Params& p, char* lds, bool dry = false) { for (int blk = blockIdx.x; blk < T / 128; blk += gridDim.x) route_block(p, blk, lds, dry); }
DEV void ph_attn_a(const Params& p, char* lds, bf16_t* dummy = nullptr) {
  const int wid = TIDX >> 6; char* vl = lds + wid * 15360;
  for (int u = blockIdx.x * NWV + wid; u < T / 2; u += gridDim.x * NWV) unit_attn_a4(p, u, vl, dummy);
}
__global__ void __launch_bounds__(512, 2) k_mega(Params p) {
  extern __shared__ __attribute__((aligned(16))) char lds[];
  const ldsb_t ldsl = (ldsb_t)lds;
  volatile LAS unsigned* xbw = (volatile LAS unsigned*)(lds + LDS_BYTES - 16);
  if (threadIdx.x == 0) { xbw[0] = 0u; xbw[1] = 0u; xbw[2] = 0u; xbw[3] = 0u; }
  __syncthreads();
  XcdBarrier bar = xcd_barrier_post(WSP(unsigned, OFF_BAR), xbw);
  ph_prep(p); ph_transposes(p, lds);
#if PROBE == 1
  ph_prep(p); ph_transposes(p, lds);
#endif
  xcd_barrier(bar);
#if PROBE == 20
  xcd_barrier(bar);
#endif
  ph_gemm1(p, ldsl);
#if PROBE == 2
  ph_gemm1(p, ldsl);
#endif
  xcd_barrier(bar);
#if PROBE == 20
  xcd_barrier(bar);
#endif
#if PROBE == 3
  ph_topk(p, lds);
#endif
#if PROBE == 4
  ph_attn_blk(p, lds, (bf16_t*)p.out + (size_t)32 * MiB);
#endif
  ph_topk(p, lds); ph_attn_blk(p, lds);
  xcd_barrier(bar);
#if PROBE == 20
  xcd_barrier(bar);
#endif
#if PROBE == 5 || PROBE == 41 || PROBE == 42
  ph_attn_a(p, lds, WSP(bf16_t, OFF_IQ)); __syncthreads();
#endif
#if PROBE == 6
  ph_gates(p, ldsl);
#endif
#if PROBE == 21
  ph_gates_probe<1>(p, ldsl);
#endif
#if PROBE == 22
  ph_gates_probe<2>(p, ldsl);
#endif
#if PROBE == 23
  ph_gates_probe<3>(p, ldsl);
#endif
  ph_gates(p, ldsl); ph_attn_a(p, lds); ph_mergeb(p);
#if PROBE == 14
  ph_mergeb(p);
#endif
  xcd_barrier(bar);
#if PROBE == 20
  xcd_barrier(bar);
#endif
  ph_branch(p, ldsl);
#if PROBE == 7
  ph_branch(p, ldsl);
#endif
  xcd_barrier(bar);
#if PROBE == 20
  xcd_barrier(bar);
#endif
  ph_out(p, ldsl);
#if PROBE == 8
  ph_out(p, ldsl);
#endif
  xcd_barrier(bar);
#if PROBE == 20
  xcd_barrier(bar);
#endif
#if PROBE == 13
  ph_route(p, lds, true);
#endif
  ph_route(p, lds);
  xcd_barrier(bar);
#if PROBE == 20
  xcd_barrier(bar);
#endif
  ph_up(p, ldsl);
#if PROBE == 9
  ph_up(p, ldsl);
#endif
  xcd_barrier(bar);
#if PROBE == 20
  xcd_barrier(bar);
#endif
  ph_down(p, ldsl);
#if PROBE == 10
  ph_down(p, ldsl);
#endif
  xcd_barrier(bar);
#if PROBE == 20
  xcd_barrier(bar);
#endif
#if PROBE == 15
  ph_final(p, true);
#endif
  ph_final(p);
}

extern "C" void kernel_launch(void* const* d_in, const int* in_sizes, int n_in, void* d_out, int out_size, void* d_ws, size_t ws_size, hipStream_t stream) {
  (void)in_sizes; (void)n_in; (void)out_size;
  if (ws_size < OFF_END) { fprintf(stderr, "workspace too small: %zu < %zu\n", ws_size, (size_t)OFF_END); return; }
  Params p{};
  p.x = (const float*)d_in[0]; p.mem = (const float*)d_in[1]; p.g_mix = (const float*)d_in[2]; p.g_mem = (const float*)d_in[3];
  p.w_in = (const float*)d_in[4]; p.w_mem_kv = (const float*)d_in[5]; p.w_gate = (const float*)d_in[6]; p.b_gate = (const float*)d_in[7];
  p.w_branch = (const float*)d_in[8]; p.w_out = (const float*)d_in[9]; p.g_ffn = (const float*)d_in[10]; p.w_group = (const float*)d_in[11];
  p.b_group = (const float*)d_in[12]; p.w_sub = (const float*)d_in[13]; p.b_sub = (const float*)d_in[14]; p.w1 = (const float*)d_in[15];
  p.w3 = (const float*)d_in[16]; p.w2 = (const float*)d_in[17]; p.g_final = (const float*)d_in[18];
  p.out = (float*)d_out; p.ws = (char*)d_ws;
  static int grid = 0;
  if (!grid) {
    int dev = 0, cus = 0, per_cu = 0;
    (void)hipGetDevice(&dev);
    (void)hipDeviceGetAttribute(&cus, hipDeviceAttributeMultiprocessorCount, dev);
    (void)hipFuncSetAttribute((const void*)k_mega, hipFuncAttributeMaxDynamicSharedMemorySize, LDS_BYTES);
    (void)hipOccupancyMaxActiveBlocksPerMultiprocessor(&per_cu, k_mega, NTH, LDS_BYTES);
    if (per_cu > 1) per_cu = 1;
    if (per_cu < 1) per_cu = 1;
    grid = cus * per_cu;
  }
  (void)hipMemsetAsync(d_ws, 0, 32768, stream);
  k_mega<<<grid, NTH, LDS_BYTES, stream>>>(p);
}
```

```cpp
#include <hip/hip_runtime.h>
#include <stdint.h>
#include <stdio.h>

#define PROBE 0
#define DEV __device__ __forceinline__
typedef unsigned short bf16_t;
typedef short bf16x8 __attribute__((ext_vector_type(8)));
typedef float f32x4 __attribute__((ext_vector_type(4)));
typedef float f32x2 __attribute__((ext_vector_type(2)));
typedef unsigned u32x4 __attribute__((ext_vector_type(4)));
typedef unsigned u32x2 __attribute__((ext_vector_type(2)));
typedef __bf16 bf16x2_t __attribute__((ext_vector_type(2)));

DEV int tid_opaque() { int t = threadIdx.x; asm volatile("" : "+v"(t)); return t; }
#define TIDX tid_opaque()
DEV float bf2f(bf16_t v) { return __uint_as_float(((unsigned)v) << 16); }
DEV unsigned pk2(float lo, float hi) { f32x2 v = {lo, hi}; bf16x2_t b = __builtin_convertvector(v, bf16x2_t); return __builtin_bit_cast(unsigned, b); }
DEV bf16_t f2bf(float f) { return (bf16_t)(pk2(f, 0.f) & 0xFFFFu); }
DEV u32x2 pk4(f32x4 v) { u32x2 r; r.x = pk2(v[0], v[1]); r.y = pk2(v[2], v[3]); return r; }
DEV f32x4 unpk4(u32x2 r) { f32x4 v; v[0] = __uint_as_float(r.x << 16); v[1] = __uint_as_float(r.x & 0xFFFF0000u); v[2] = __uint_as_float(r.y << 16); v[3] = __uint_as_float(r.y & 0xFFFF0000u); return v; }
DEV u32x4 pk8(const f32x4& a, const f32x4& b) { u32x4 r; r.x = pk2(a[0], a[1]); r.y = pk2(a[2], a[3]); r.z = pk2(b[0], b[1]); r.w = pk2(b[2], b[3]); return r; }
DEV void unpk8(const u32x4& r, f32x4& a, f32x4& b) {
  a[0] = __uint_as_float(r.x << 16); a[1] = __uint_as_float(r.x & 0xFFFF0000u); a[2] = __uint_as_float(r.y << 16); a[3] = __uint_as_float(r.y & 0xFFFF0000u);
  b[0] = __uint_as_float(r.z << 16); b[1] = __uint_as_float(r.z & 0xFFFF0000u); b[2] = __uint_as_float(r.w << 16); b[3] = __uint_as_float(r.w & 0xFFFF0000u); }

DEV float wave_sum(float v) {
#pragma unroll
  for (int o = 32; o >= 1; o >>= 1) v += __shfl_xor(v, o);
  return v;
}

constexpr int NB = 4, S = 8192, T = NB * S, D = 1024, S_ = S;
constexpr int NTH = 512, NWV = 8;
constexpr int INW = 6212;
constexpr float RMS_EPS = 1e-6f;
constexpr int C_AQ = 0, C_AK = 512, C_AV = 640, C_IQ = 768, C_IK = 1024, C_BQ = 1088, C_BK = 2624, C_BV = 4160, C_MQ = 5696, C_IW = 6208, C_END = 6212;

constexpr size_t MiB = 1048576;
constexpr size_t OFF_BAR = 0;
constexpr size_t OFF_CNT = 16384;
constexpr size_t OFF_WR = 65536;
constexpr size_t OFF_WIN = 1 * MiB;
constexpr size_t OFF_WG = OFF_WIN + 13 * MiB;
constexpr size_t OFF_WB = OFF_WG + 6 * MiB;
constexpr size_t OFF_WO = OFF_WB + 3 * MiB;
constexpr size_t OFF_WM = OFF_WO + 2 * MiB;
constexpr size_t OFF_W13 = OFF_WM + 2 * MiB;
constexpr size_t OFF_W2 = OFF_W13 + 32 * MiB;
constexpr size_t OFF_ROPE = OFF_W2 + 16 * MiB;
constexpr size_t OFF_MEMN = OFF_ROPE + 2 * MiB;
constexpr size_t OFF_KV = OFF_MEMN + 2 * MiB;
constexpr size_t OFF_LIST = OFF_KV + 2 * MiB;
constexpr size_t OFF_CW = OFF_LIST + 2 * MiB;
constexpr size_t OFF_IW = OFF_CW + 1 * MiB;
constexpr size_t OFF_LSE = OFF_IW + 1 * MiB;
constexpr size_t OFF_SEL = OFF_LSE + 3 * MiB;
constexpr size_t OFF_AQ = OFF_SEL + 16 * MiB;
constexpr size_t OFF_AK = OFF_AQ + 32 * MiB;
constexpr size_t OFF_AV = OFF_AK + 8 * MiB;
constexpr size_t OFF_IQ = OFF_AV + 8 * MiB;
constexpr size_t OFF_IK = OFF_IQ + 16 * MiB;
constexpr size_t OFF_BQ = OFF_IK + 4 * MiB;
constexpr size_t OFF_MQ = OFF_BQ + 96 * MiB;
constexpr size_t OFF_BK = OFF_MQ + 32 * MiB;
constexpr size_t OFF_BV = OFF_BK + 96 * MiB;
constexpr size_t OFF_END = OFF_BV + 96 * MiB;
constexpr size_t OFF_YB = OFF_AK, OFF_MERGED = OFF_BQ, OFF_MOE = OFF_BQ, OFF_GATES = OFF_BK, OFF_HN = OFF_BK, OFF_HID = OFF_BK + 64 * MiB;
static_assert(OFF_END <= 512 * MiB, "workspace overflow");

struct Params {
  const float *x, *mem, *g_mix, *g_mem, *w_in, *w_mem_kv, *w_gate, *b_gate, *w_branch, *w_out, *g_ffn, *w_group, *b_group, *w_sub, *b_sub, *w1, *w3, *w2, *g_final;
  float* out;
  char* ws;
};
#define WSP(T_, off) ((T_*)(p.ws + (off)))

DEV void ph_prep(const Params& p) {
  const int lane = TIDX & 63, gw = (blockIdx.x * NTH + TIDX) >> 6, nw = (gridDim.x * NTH) >> 6;
  bf16_t* n = (bf16_t*)p.out;
  bf16_t* memn = WSP(bf16_t, OFF_MEMN);
  for (int r = gw; r < T + NB * 256; r += nw) {
    const bool isx = r < T;
    const float* src = isx ? p.x + (size_t)r * D : p.mem + (size_t)(r - T) * D;
    const float* g = isx ? p.g_mix : p.g_mem;
    bf16_t* dst = isx ? n + (size_t)r * D : memn + (size_t)(r - T) * D;
    f32x4 v[4]; float ss = 0.f;
#pragma unroll
    for (int i = 0; i < 4; ++i) { v[i] = *(const f32x4*)(src + i * 256 + lane * 4); ss += v[i][0] * v[i][0] + v[i][1] * v[i][1] + v[i][2] * v[i][2] + v[i][3] * v[i][3]; }
    ss = wave_sum(ss);
    const float rstd = 1.0f / sqrtf(ss * (1.0f / D) + RMS_EPS);
#pragma unroll
    for (int i = 0; i < 4; ++i) { const f32x4 gg = *(const f32x4*)(g + i * 256 + lane * 4); f32x4 o = v[i] * rstd * gg; *(u32x2*)(dst + i * 256 + lane * 4) = pk4(o); }
  }
  f32x2* rope = WSP(f32x2, OFF_ROPE);
  for (int i = blockIdx.x * NTH + TIDX; i < S * 32; i += gridDim.x * NTH) {
    const int pos = i >> 5, j = i & 31;
    const double inv = exp2(-(double)j * (13.287712379549449 / 32.0));
    const double ang = (double)pos * inv;
    double rev = ang * 0.15915494309189535; rev -= floor(rev);
    const float rf = (float)rev;
    f32x2 cs; cs.x = __builtin_amdgcn_cosf(rf); cs.y = __builtin_amdgcn_sinf(rf);
    rope[i] = cs;
  }
  bf16_t* wr = WSP(bf16_t, OFF_WR);
  for (int i = blockIdx.x * NTH + TIDX; i < 32 * 1024; i += gridDim.x * NTH) {
    const int n = i >> 10, k = i & 1023;
    float w = 0.f;
    if (n < 4) w = p.w_group[k * 4 + n]; else if (n < 20) w = p.w_sub[((size_t)((n - 4) >> 2) * 1024 + k) * 4 + ((n - 4) & 3)];
    w *= p.g_ffn[k];
    const bf16_t hi = f2bf(w); const bf16_t lo = f2bf(w - bf2f(hi));
    wr[i] = hi; wr[32 * 1024 + i] = lo;
  }
}

DEV bool g1_dest(const Params& p, int c, bf16_t*& base, int& ld, int& lc, bool& rope) {
  if (c < C_AK) { base = WSP(bf16_t, OFF_AQ); ld = 512; lc = c - C_AQ; rope = true; }
  else if (c < C_AV) { base = WSP(bf16_t, OFF_AK); ld = 128; lc = c - C_AK; rope = true; }
  else if (c < C_IQ) { base = WSP(bf16_t, OFF_AV); ld = 128; lc = c - C_AV; rope = false; }
  else if (c < C_IK) { base = WSP(bf16_t, OFF_IQ); ld = 256; lc = c - C_IQ; rope = true; }
  else if (c < C_BQ) { base = WSP(bf16_t, OFF_IK); ld = 64; lc = c - C_IK; rope = true; }
  else if (c < C_BK) { base = WSP(bf16_t, OFF_BQ); ld = 1536; lc = c - C_BQ; rope = true; }
  else if (c < C_BV) { base = WSP(bf16_t, OFF_BK); ld = 1536; lc = c - C_BK; rope = true; }
  else if (c < C_MQ) { base = WSP(bf16_t, OFF_BV); ld = 1536; lc = c - C_BV; rope = false; }
  else if (c < C_IW) { base = WSP(bf16_t, OFF_MQ); ld = 512; lc = c - C_MQ; rope = false; }
  else return false;
  return true;
}
DEV int src_col(int c) { return c < C_BQ ? c : (c < C_IW ? c + 4 : c - C_IW + 1088); }

DEV unsigned f2key(float s) { const unsigned u = __float_as_uint(s); return (u & 0x80000000u) ? ~u : (u | 0x80000000u); }

DEV void route_block(const Params& p, int blk, char* lds, bool dry = false) {
  int* tok_e = (int*)lds;
  float* tok_w = (float*)(lds + 1024);
  int* lcnt = (int*)(lds + 2048);
  int* gbase = (int*)(lds + 2112);
  int* rank = (int*)(lds + 2176);
  const int tid = TIDX, lane = tid & 63, wid = tid >> 6;
  const float* h1 = p.out; bf16_t* hn = WSP(bf16_t, OFF_HN);
  if (tid < 16) lcnt[tid] = 0;
  {
    const int fr = lane & 15, fq = lane >> 4;
    const int tok = blk * 128 + wid * 16 + fr;
    const float* xr = h1 + (size_t)tok * D + 8 * fq;
    const bf16_t* wh = WSP(bf16_t, OFF_WR) + (size_t)fr * 1024 + 8 * fq;
    f32x4 lg0 = {0.f, 0.f, 0.f, 0.f}, lg1 = {0.f, 0.f, 0.f, 0.f}; float ss = 0.f;
#pragma unroll 2
    for (int ks = 0; ks < 32; ++ks) {
      const f32x4 x0 = *(const f32x4*)(xr + 32 * ks), x1 = *(const f32x4*)(xr + 32 * ks + 4);
      const bf16x8 wh0 = *(const bf16x8*)(wh + 32 * ks), wh1 = *(const bf16x8*)(wh + 16 * 1024 + 32 * ks);
      const bf16x8 wl0 = *(const bf16x8*)(wh + 32 * 1024 + 32 * ks), wl1 = *(const bf16x8*)(wh + 48 * 1024 + 32 * ks);
      ss += x0[0] * x0[0] + x0[1] * x0[1] + x0[2] * x0[2] + x0[3] * x0[3] + x1[0] * x1[0] + x1[1] * x1[1] + x1[2] * x1[2] + x1[3] * x1[3];
      u32x4 ph; ph.x = pk2(x0[0], x0[1]); ph.y = pk2(x0[2], x0[3]); ph.z = pk2(x1[0], x1[1]); ph.w = pk2(x1[2], x1[3]);
      f32x4 h0, h1v; unpk8(ph, h0, h1v);
      const f32x4 r0 = x0 - h0, r1 = x1 - h1v;
      u32x4 pl; pl.x = pk2(r0[0], r0[1]); pl.y = pk2(r0[2], r0[3]); pl.z = pk2(r1[0], r1[1]); pl.w = pk2(r1[2], r1[3]);
      const bf16x8 xh = __builtin_bit_cast(bf16x8, ph), xl = __builtin_bit_cast(bf16x8, pl);
      lg0 = __builtin_amdgcn_mfma_f32_16x16x32_bf16(wh0, xh, lg0, 0, 0, 0); lg0 = __builtin_amdgcn_mfma_f32_16x16x32_bf16(wl0, xh, lg0, 0, 0, 0); lg0 = __builtin_amdgcn_mfma_f32_16x16x32_bf16(wh0, xl, lg0, 0, 0, 0);
      lg1 = __builtin_amdgcn_mfma_f32_16x16x32_bf16(wh1, xh, lg1, 0, 0, 0); lg1 = __builtin_amdgcn_mfma_f32_16x16x32_bf16(wl1, xh, lg1, 0, 0, 0); lg1 = __builtin_amdgcn_mfma_f32_16x16x32_bf16(wh1, xl, lg1, 0, 0, 0);
    }
    ss += __shfl_xor(ss, 16); ss += __shfl_xor(ss, 32);
    const float rstd = 1.0f / sqrtf(ss * (1.0f / D) + RMS_EPS);
    float* lgs = (float*)(lds + 4096) + wid * 512;
    *(f32x4*)(lgs + fr * 32 + 4 * fq) = lg0; *(f32x4*)(lgs + fr * 32 + 16 + 4 * fq) = lg1;
    float lgv[20];
#pragma unroll
    for (int j = 0; j < 5; ++j) { const f32x4 v = *(const f32x4*)(lgs + fr * 32 + 4 * j); lgv[4 * j] = v[0]; lgv[4 * j + 1] = v[1]; lgv[4 * j + 2] = v[2]; lgv[4 * j + 3] = v[3]; }
    {
      float gl[4];
#pragma unroll
      for (int g = 0; g < 4; ++g) gl[g] = lgv[g] * rstd + p.b_group[g];
      int gs = 0; float gm = gl[0];
#pragma unroll
      for (int g = 1; g < 4; ++g) if (gl[g] > gm) { gm = gl[g]; gs = g; }
      float gden = 0.f;
#pragma unroll
      for (int g = 0; g < 4; ++g) gden += __expf(gl[g] - gm);
      const float gw = 1.0f / gden;
      float sl[4];
#pragma unroll
      for (int e = 0; e < 4; ++e) { float v = 0.f;
#pragma unroll
        for (int g = 0; g < 4; ++g) v = (gs == g) ? lgv[4 + 4 * g + e] * rstd + p.b_sub[g * 4 + e] : v;
        sl[e] = v; }
      int e0 = 0; float m0 = sl[0];
#pragma unroll
      for (int e = 1; e < 4; ++e) if (sl[e] > m0) { m0 = sl[e]; e0 = e; }
      int e1 = -1; float m1 = -INFINITY;
#pragma unroll
      for (int e = 0; e < 4; ++e) if (e != e0 && sl[e] > m1) { m1 = sl[e]; e1 = e; }
      const float p1 = __expf(m1 - m0);
      const float w0 = gw / (1.0f + p1), w1 = gw * p1 / (1.0f + p1);
      if (fq == 0) { const int tl = wid * 16 + fr; tok_e[tl * 2] = gs * 4 + e0; tok_e[tl * 2 + 1] = gs * 4 + e1; tok_w[tl * 2] = w0; tok_w[tl * 2 + 1] = w1; }
    }
#pragma unroll 4
    for (int ks = 0; ks < 32; ++ks) {
      const f32x4 x0 = *(const f32x4*)(xr + 32 * ks), x1 = *(const f32x4*)(xr + 32 * ks + 4);
      const f32x4 g0 = *(const f32x4*)(p.g_ffn + 32 * ks + 8 * fq), g1 = *(const f32x4*)(p.g_ffn + 32 * ks + 8 * fq + 4);
      *(u32x4*)(hn + (size_t)tok * D + 32 * ks + 8 * fq) = pk8(x0 * rstd * g0, x1 * rstd * g1);
    }
  }
  __syncthreads();
  if (tid < 256) rank[tid] = atomicAdd(&lcnt[tok_e[tid]], 1);
  __syncthreads();
  if (tid < 16 && !dry) gbase[tid] = (int)__hip_atomic_fetch_add(WSP(unsigned, OFF_CNT) + tid, (unsigned)lcnt[tid], __ATOMIC_RELAXED, __HIP_MEMORY_SCOPE_AGENT);
  __syncthreads();
  if (tid < 256 && !dry) {
    const int e = tok_e[tid], ent = (blk * 128 + (tid >> 1)) * 2 + (tid & 1);
    WSP(int, OFF_LIST)[(size_t)e * T + gbase[e] + rank[tid]] = ent;
    WSP(float, OFF_CW)[ent] = tok_w[tid];
  }
  __syncthreads();
}
DEV void ph_final(const Params& p, bool dry = false) {
  const int lane = TIDX & 63, gw = (blockIdx.x * NTH + TIDX) >> 6, nw = (gridDim.x * NTH) >> 6;
  const bf16_t* moe = WSP(bf16_t, OFF_MOE);
  for (int r = gw; r < T; r += nw) {
    f32x4 v[4]; float ss = 0.f;
#pragma unroll
    for (int i = 0; i < 4; ++i) {
      const int c = i * 256 + lane * 4;
      v[i] = *(const f32x4*)(p.out + (size_t)r * D + c) + unpk4(*(const u32x2*)(moe + (size_t)(2 * r) * D + c)) + unpk4(*(const u32x2*)(moe + (size_t)(2 * r + 1) * D + c));
      ss += v[i][0] * v[i][0] + v[i][1] * v[i][1] + v[i][2] * v[i][2] + v[i][3] * v[i][3];
    }
    ss = wave_sum(ss);
    const float rstd = 1.0f / sqrtf(ss * (1.0f / D) + RMS_EPS);
#pragma unroll
    for (int i = 0; i < 4; ++i) { const int c = i * 256 + lane * 4; float* dst = dry ? WSP(float, OFF_HID) + ((size_t)r * D & (8 * MiB - 1)) + c : p.out + (size_t)r * D + c; *(f32x4*)dst = v[i] * rstd * *(const f32x4*)(p.g_final + c); }
  }
}


constexpr int LDS_BYTES = 143360;
constexpr int NIN_PAD = 6400;
__host__ __device__ __forceinline__ int perm256(int rho) { const int r = rho & 255; return (rho & ~255) + ((r >> 5) & 3) * 64 + (r >> 7) * 32 + ((r >> 2) & 3) * 8 + ((r >> 4) & 1) * 4 + (r & 3); }

DEV void ph_transposes(const Params& p, char* lds) {
  const int tid = TIDX, half = tid >> 8, t = tid & 255;
  float* tile = (float*)(lds + half * 16640);
  constexpr int J0 = 100 * 16, J1 = J0 + 48 * 16, J2 = J1 + 3 * 16 * 8, J3 = J2 + 256, J4 = J3 + 256, J5 = J4 + 16 * 256, J6 = J5 + 16 * 128;
  static_assert((J6 & 1) == 0, "job count must be even");
  for (int jb = blockIdx.x; jb < J6 / 2; jb += gridDim.x) {
    const int job = jb * 2 + half;
    const float* s0; const float* s1 = nullptr; int lds_ = 1024, ldd = 1024, n0, k0, mode = 1; bf16_t* dst;
    if (job < J0) { const int nt = job / 16, kt = job % 16; s0 = p.w_in; lds_ = INW; dst = WSP(bf16_t, OFF_WIN); n0 = nt * 64; k0 = kt * 64; mode = 0; }
    else if (job < J1) { const int j = job - J0, nt = j / 16, kt = j % 16; s0 = p.w_gate; lds_ = 3072; dst = WSP(bf16_t, OFF_WG); n0 = nt * 64; k0 = kt * 64; }
    else if (job < J2) { const int j = job - J1, br = j / 128, r = j % 128, nt = r / 8, kt = r % 8; s0 = p.w_branch + (size_t)br * 512 * 1024; dst = WSP(bf16_t, OFF_WB) + (size_t)br * 1024 * 512; ldd = 512; n0 = nt * 64; k0 = kt * 64; }
    else if (job < J3) { const int j = job - J2, nt = j / 16, kt = j % 16; s0 = p.w_out; dst = WSP(bf16_t, OFF_WO); n0 = nt * 64; k0 = kt * 64; }
    else if (job < J4) { const int j = job - J3, nt = j / 16, kt = j % 16; s0 = p.w_mem_kv; dst = WSP(bf16_t, OFF_WM); n0 = nt * 64; k0 = kt * 64; }
    else if (job < J5) { const int j = job - J4, e = j / 256, r = j % 256, nt = r / 16, kt = r % 16; s0 = p.w1 + (size_t)e * 1024 * 512; s1 = p.w3 + (size_t)e * 1024 * 512; lds_ = 512;
      dst = WSP(bf16_t, OFF_W13) + (size_t)e * 1024 * 1024; n0 = nt * 64; k0 = kt * 64; mode = 2; }
    else { const int j = job - J5, e = j / 128, r = j % 128, nt = r / 8, kt = r % 8; s0 = p.w2 + (size_t)e * 512 * 1024; dst = WSP(bf16_t, OFF_W2) + (size_t)e * 1024 * 512; ldd = 512; n0 = nt * 64; k0 = kt * 64; }
    const int v = perm256(n0 + 4 * (t & 15));
    const float* sp; bool zero = false;
    if (mode == 0) { zero = v >= C_END; sp = s0 + (zero ? 0 : src_col(v)); }
    else if (mode == 1) sp = s0 + v;
    else { const int hidn = (v >> 8) * 128 + ((v >> 6) & 3) * 32 + (v & 31); sp = (((v >> 5) & 1) ? s1 : s0) + hidn; }
#pragma unroll
    for (int i = 0; i < 4; ++i) { const int kk = (t >> 4) + 16 * i; const f32x4 x = zero ? (f32x4){0.f, 0.f, 0.f, 0.f} : *(const f32x4*)(sp + (size_t)(k0 + kk) * lds_);
      float* tp = tile + kk * 65 + 4 * (t & 15); tp[0] = x[0]; tp[1] = x[1]; tp[2] = x[2]; tp[3] = x[3]; }
    __syncthreads();
    const int n = t >> 2, kc = (t & 3) * 16;
    float vv[16];
#pragma unroll
    for (int j = 0; j < 16; ++j) vv[j] = tile[(kc + j) * 65 + n];
    u32x4 o0, o1;
    o0.x = pk2(vv[0], vv[1]); o0.y = pk2(vv[2], vv[3]); o0.z = pk2(vv[4], vv[5]); o0.w = pk2(vv[6], vv[7]);
    o1.x = pk2(vv[8], vv[9]); o1.y = pk2(vv[10], vv[11]); o1.z = pk2(vv[12], vv[13]); o1.w = pk2(vv[14], vv[15]);
    bf16_t* dd = dst + (size_t)(n0 + n) * ldd + k0 + kc;
    *(u32x4*)dd = o0; *(u32x4*)(dd + 8) = o1;
    __syncthreads();
  }
}
typedef __attribute__((address_space(3))) unsigned char* ldsb_t;
constexpr int HTB = 128 * 64 * 2;
DEV int lds_byte(int r, int c) { return r * 128 + ((((c >> 3) ^ (r >> 1)) & 7) << 4); }
DEV void stage_rc(int b, int& R, int& C) { R = b >> 7; C = ((((b >> 4) & 7) ^ (R >> 1)) & 7) * 8; }
struct Unit { int pm, pn, aux, ne; };
struct StaticOrder {
  int nM, nN, nwg, G, c;
  DEV void init(int nM_, int nN_, int G_, int c_) { nM = nM_; nN = nN_; nwg = nM * nN; G = G_; c = c_; }
  DEV bool next(int i, int& pm, int& pn) const {
    const long L = (long)i * G + c; if (L >= nwg) return false;
    int wgid = (int)L; { const int q = nwg / 8, r = nwg % 8, xcd = wgid % 8, off = wgid / 8; wgid = (xcd < r ? xcd * (q + 1) : r * (q + 1) + (xcd - r) * q) + off; }
    const int nig = 8 * nN, gid = wgid / nig, fm = gid * 8, gsz = (nM - fm) < 8 ? (nM - fm) : 8;
    pm = fm + ((wgid % nig) % gsz); pn = (wgid % nig) / gsz; return true;
  }
};
typedef f32x4 acc_t[2][2][4][2];
template <class DD>
DEV void gemm256(ldsb_t lds, const DD& d) {
  const int tid = TIDX, wid = __builtin_amdgcn_readfirstlane(tid >> 6), lane = tid & 63, wr = wid >> 2, wc = wid & 3, fr = lane & 15, fq = lane >> 4;
  const int K = d.K, nt = K / 64;
  int Rst[2]; unsigned Cst[2], voffB[2];
#pragma unroll
  for (int i = 0; i < 2; ++i) { int R, C; stage_rc(tid * 16 + i * 8192, R, C); Rst[i] = R; Cst[i] = (unsigned)C * 2u; voffB[i] = (unsigned)(R * K + C) * 2u; }
  const size_t kstep = 128, hstep = (size_t)128 * K * 2;
  const unsigned ldsw = (unsigned)wid * 1024u;
  const int aoff = lds_byte(wr * 64 + fr, fq * 8), boff = lds_byte(wc * 32 + fr, fq * 8);
#define G_SA(b, h) (((b) * 2 + (h)) * HTB)
#define G_SB(b, h) ((4 + (b) * 2 + (h)) * HTB)
#define G_STAGEB(bufoff, gbase) do { _Pragma("unroll") for (int _i = 0; _i < 2; ++_i) \
    __builtin_amdgcn_global_load_lds((const unsigned*)((const char*)(gbase) + voffB[_i]), (__attribute__((address_space(3))) unsigned*)(lds + (bufoff) + ldsw + _i * 8192), 16, 0, 0); } while (0)
#define G_STAGEA(bufoff, gbase, ao, h, kb) do { _Pragma("unroll") for (int _i = 0; _i < 2; ++_i) \
    __builtin_amdgcn_global_load_lds((const unsigned*)((const char*)(gbase) + (ao)[h][_i] + (kb)), (__attribute__((address_space(3))) unsigned*)(lds + (bufoff) + ldsw + _i * 8192), 16, 0, 0); } while (0)
#define G_LDA(dst, b, h) do { _Pragma("unroll") for (int m = 0; m < 4; ++m) _Pragma("unroll") for (int k = 0; k < 2; ++k) dst[m][k] = *(const __attribute__((address_space(3))) bf16x8*)(lds + G_SA(b, h) + ((aoff ^ (k << 6)) + m * 2048)); } while (0)
#define G_LDB(dst, b, h) do { _Pragma("unroll") for (int n = 0; n < 2; ++n) _Pragma("unroll") for (int k = 0; k < 2; ++k) dst[n][k] = *(const __attribute__((address_space(3))) bf16x8*)(lds + G_SB(b, h) + ((boff ^ (k << 6)) + n * 2048)); } while (0)
#define G_MMA(ai, bj, At, Bt) do { __builtin_amdgcn_s_setprio(1); _Pragma("unroll") for (int m = 0; m < 4; ++m) _Pragma("unroll") for (int n = 0; n < 2; ++n) _Pragma("unroll") for (int k = 0; k < 2; ++k) \
    acc[ai][bj][m][n] = __builtin_amdgcn_mfma_f32_16x16x32_bf16(Bt[n][k], At[m][k], acc[ai][bj][m][n], 0, 0, 0); __builtin_amdgcn_s_setprio(0); } while (0)
#define G_WAIT_V(n) asm volatile("s_waitcnt vmcnt(" #n ")" ::: "memory")
#define G_WAIT_L(n) asm volatile("s_waitcnt lgkmcnt(" #n ")" ::: "memory")
#define G_BAR __builtin_amdgcn_s_barrier()
#define G_SCHED __builtin_amdgcn_sched_barrier(0)
#define G_ZERO() _Pragma("unroll") for (int a_ = 0; a_ < 2; ++a_) _Pragma("unroll") for (int b_ = 0; b_ < 2; ++b_) _Pragma("unroll") for (int m_ = 0; m_ < 4; ++m_) _Pragma("unroll") for (int n_ = 0; n_ < 2; ++n_) acc[a_][b_][m_][n_] = (f32x4){0.f, 0.f, 0.f, 0.f}
  Unit cur, nxt; int ui = 0;
  if (!d.next(0, cur)) return;
  acc_t acc; G_ZERO();
  bf16x8 At[4][2], B0[2][2], B1[2][2];
  unsigned aoC[2][2], aoN[2][2];
#pragma unroll
  for (int h = 0; h < 2; ++h)
#pragma unroll
    for (int i = 0; i < 2; ++i) aoC[h][i] = d.arow(cur, h * 128 + Rst[i]) + Cst[i];
  const char* cA = d.abase(cur); const char* cB = d.bbase(cur);
  G_STAGEB(G_SB(0, 0), cB); G_STAGEB(G_SB(0, 1), cB + hstep); G_STAGEA(G_SA(0, 0), cA, aoC, 0, 0); G_STAGEA(G_SA(0, 1), cA, aoC, 1, 0);
  if (wr == 1) G_BAR;
  G_WAIT_V(2); G_BAR;
  G_STAGEB(G_SB(1, 0), cB + kstep); G_STAGEA(G_SA(1, 0), cA, aoC, 0, kstep); G_STAGEB(G_SB(1, 1), cB + hstep + kstep);
  G_WAIT_V(6); G_BAR;
  for (;;) {
    const bool has_next = d.next(ui + 1, nxt);
    const char* nA = has_next ? d.abase(nxt) : cA; const char* nB = has_next ? d.bbase(nxt) : cB;
#pragma unroll
    for (int h = 0; h < 2; ++h)
#pragma unroll
      for (int i = 0; i < 2; ++i) aoN[h][i] = has_next ? d.arow(nxt, h * 128 + Rst[i]) + Cst[i] : aoC[h][i];
    for (int t = 0; t < nt; t += 2) {
      const bool last = (t == nt - 2);
      const size_t k1 = (size_t)(t + 1) * kstep;
      const size_t k2 = last ? 0 : (size_t)(t + 2) * kstep, k3 = k2 + kstep;
      const char* a2 = last ? nA : cA; const char* b2 = last ? nB : cB + k2; const char* b3 = b2 + kstep;
      unsigned ao2[2][2];
#pragma unroll
      for (int h = 0; h < 2; ++h)
#pragma unroll
        for (int i = 0; i < 2; ++i) ao2[h][i] = last ? aoN[h][i] : aoC[h][i];
      G_LDB(B0, 0, 0); G_LDB(B1, 0, 1); G_SCHED; G_LDA(At, 0, 0); G_STAGEA(G_SA(1, 1), cA, aoC, 1, k1);
      G_WAIT_V(8); G_WAIT_L(0); G_BAR; G_MMA(0, 0, At, B0); G_MMA(0, 1, At, B1); G_BAR; G_SCHED;
      G_LDA(At, 0, 1); G_STAGEB(G_SB(0, 0), b2); G_STAGEB(G_SB(0, 1), b2 + hstep); G_STAGEA(G_SA(0, 0), a2, ao2, 0, k2);
      G_WAIT_V(8); G_WAIT_L(0); G_BAR; G_MMA(1, 0, At, B0); G_MMA(1, 1, At, B1); G_BAR; G_SCHED;
      G_LDB(B0, 1, 0); G_LDB(B1, 1, 1); G_SCHED; G_LDA(At, 1, 0); G_STAGEA(G_SA(0, 1), a2, ao2, 1, k2);
      G_WAIT_V(8); G_WAIT_L(0); G_BAR; G_MMA(0, 0, At, B0); G_MMA(0, 1, At, B1); G_BAR; G_SCHED;
      G_LDA(At, 1, 1); G_STAGEB(G_SB(1, 0), b3); G_STAGEB(G_SB(1, 1), b3 + hstep); G_STAGEA(G_SA(1, 0), a2, ao2, 0, k3);
      G_WAIT_V(8); G_WAIT_L(0); G_BAR; G_MMA(1, 0, At, B0); G_MMA(1, 1, At, B1); G_BAR; G_SCHED;
    }
    if (wr == 0) G_BAR;
    d.epi(acc, cur, wr, wc, fr, fq);
    if (!has_next) break;
    G_ZERO();
    cur = nxt; cA = nA; cB = nB; ++ui;
#pragma unroll
    for (int h = 0; h < 2; ++h)
#pragma unroll
      for (int i = 0; i < 2; ++i) aoC[h][i] = aoN[h][i];
    if (wr == 1) G_BAR;
  }
  G_WAIT_V(0);
  G_BAR;
}

struct DGemm1 {
  const Params& p; int K; StaticOrder S;
  DEV bool next(int i, Unit& u) const { return S.next(i, u.pm, u.pn); }
  DEV const char* abase(const Unit&) const { return (const char*)p.out; }
  DEV unsigned arow(const Unit& u, int r) const { return (unsigned)(u.pm * 256 + r) * 2048u; }
  DEV const char* bbase(const Unit& u) const { return p.ws + OFF_WIN + (size_t)u.pn * 256 * 2048; }
  DEV void epi(const acc_t& acc, const Unit& u, int wr, int wc, int fr, int fq) const {
    const int c0 = u.pn * 256 + wc * 64;
    if (c0 < C_IW) {
      bf16_t* base; int ld, lc; bool rope; g1_dest(p, c0, base, ld, lc, rope);
      const f32x2* ropet = WSP(f32x2, OFF_ROPE);
#pragma unroll
      for (int ai = 0; ai < 2; ++ai)
#pragma unroll
        for (int m = 0; m < 4; ++m) {
          const int row = u.pm * 256 + ai * 128 + wr * 64 + m * 16 + fr;
          f32x4 lo[2] = {acc[ai][0][m][0], acc[ai][0][m][1]}, hi[2] = {acc[ai][1][m][0], acc[ai][1][m][1]};
          if (rope) {
            const int pos = row & (S_ - 1);
#pragma unroll
            for (int n = 0; n < 2; ++n) {
              const f32x4 t0 = *(const f32x4*)(ropet + pos * 32 + 8 * fq + 4 * n), t1 = *(const f32x4*)(ropet + pos * 32 + 8 * fq + 4 * n + 2);
              const float cs[4] = {t0[0], t0[2], t1[0], t1[2]}, sn[4] = {t0[1], t0[3], t1[1], t1[3]};
              const f32x4 l = lo[n], h = hi[n];
#pragma unroll
              for (int e = 0; e < 4; ++e) { lo[n][e] = l[e] * cs[e] - h[e] * sn[e]; hi[n][e] = h[e] * cs[e] + l[e] * sn[e]; }
            }
          }
          bf16_t* dst = base + (size_t)row * ld + lc + 8 * fq;
          __builtin_nontemporal_store(pk8(lo[0], lo[1]), (u32x4*)dst); __builtin_nontemporal_store(pk8(hi[0], hi[1]), (u32x4*)(dst + 32));
        }
    } else if (c0 == C_IW) {
      if (fq == 0) {
#pragma unroll
        for (int ai = 0; ai < 2; ++ai)
#pragma unroll
          for (int m = 0; m < 4; ++m) { const int row = u.pm * 256 + ai * 128 + wr * 64 + m * 16 + fr; *(f32x4*)(WSP(float, OFF_IW) + (size_t)row * 4) = acc[ai][0][m][0]; }
      }
    }
  }
};
struct DMemKV {
  const Params& p; int K;
  DEV bool next(int i, Unit& u) const { const int j = (int)blockIdx.x - ((int)gridDim.x - 16); if (i != 0 || j < 0) return false; u.pm = j >> 2; u.pn = j & 3; return true; }
  DEV const char* abase(const Unit&) const { return p.ws + OFF_MEMN; }
  DEV unsigned arow(const Unit& u, int r) const { return (unsigned)(u.pm * 256 + r) * 2048u; }
  DEV const char* bbase(const Unit& u) const { return p.ws + OFF_WM + (size_t)u.pn * 256 * 2048; }
  DEV void epi(const acc_t& acc, const Unit& u, int wr, int wc, int fr, int fq) const {
    bf16_t* kv = WSP(bf16_t, OFF_KV);
#pragma unroll
    for (int ai = 0; ai < 2; ++ai)
#pragma unroll
      for (int m = 0; m < 4; ++m) { const int row = u.pm * 256 + ai * 128 + wr * 64 + m * 16 + fr;
#pragma unroll
        for (int bj = 0; bj < 2; ++bj) *(u32x4*)(kv + (size_t)row * 1024 + u.pn * 256 + wc * 64 + bj * 32 + 8 * fq) = pk8(acc[ai][bj][m][0], acc[ai][bj][m][1]); }
  }
};
struct DGates {
  const Params& p; int K; StaticOrder S;
  DEV bool next(int i, Unit& u) const { return S.next(i, u.pm, u.pn); }
  DEV const char* abase(const Unit&) const { return (const char*)p.out; }
  DEV unsigned arow(const Unit& u, int r) const { return (unsigned)(u.pm * 256 + r) * 2048u; }
  DEV const char* bbase(const Unit& u) const { return p.ws + OFF_WG + (size_t)u.pn * 256 * 2048; }
  DEV void epi(const acc_t& acc, const Unit& u, int wr, int wc, int fr, int fq) const {
    bf16_t* gates = WSP(bf16_t, OFF_GATES);
#pragma unroll
    for (int bj = 0; bj < 2; ++bj) {
      const int col = u.pn * 256 + wc * 64 + bj * 32 + 8 * fq;
      const f32x4 b0 = *(const f32x4*)(p.b_gate + col), b1 = *(const f32x4*)(p.b_gate + col + 4);
#pragma unroll
      for (int ai = 0; ai < 2; ++ai)
#pragma unroll
        for (int m = 0; m < 4; ++m) {
          const int row = u.pm * 256 + ai * 128 + wr * 64 + m * 16 + fr; f32x4 o0, o1;
#pragma unroll
          for (int e = 0; e < 4; ++e) { o0[e] = 1.0f / (1.0f + __expf(-(acc[ai][bj][m][0][e] + b0[e]))); o1[e] = 1.0f / (1.0f + __expf(-(acc[ai][bj][m][1][e] + b1[e]))); }
          __builtin_nontemporal_store(pk8(o0, o1), (u32x4*)(gates + (size_t)row * 3072 + col));
        }
    }
  }
};
template <int MODE> struct DGatesProbe {
  const Params& p; int K; StaticOrder S;
  DEV bool next(int i, Unit& u) const { return S.next(i, u.pm, u.pn); }
  DEV const char* abase(const Unit&) const { return (const char*)p.out; }
  DEV unsigned arow(const Unit& u, int r) const { return (unsigned)(u.pm * 256 + r) * 2048u; }
  DEV const char* bbase(const Unit& u) const { return p.ws + OFF_WG + (size_t)u.pn * 256 * 2048; }
  DEV void epi(const acc_t& acc, const Unit& u, int wr, int wc, int fr, int fq) const {
    bf16_t* dummy = WSP(bf16_t, OFF_IQ);
    if (MODE == 1) {
      float s = 0.f;
#pragma unroll
      for (int ai = 0; ai < 2; ++ai) for (int bj = 0; bj < 2; ++bj) for (int m = 0; m < 4; ++m) for (int n = 0; n < 2; ++n) s += acc[ai][bj][m][n][0] + acc[ai][bj][m][n][3];
      if (s == 12345.678f) dummy[0] = 1;
    } else {
#pragma unroll
      for (int bj = 0; bj < 2; ++bj) {
        const int col = wc * 64 + bj * 32 + 8 * fq;
#pragma unroll
        for (int ai = 0; ai < (MODE == 3 ? 1 : 2); ++ai)
#pragma unroll
          for (int m = 0; m < 4; ++m) { const int row = ai * 128 + wr * 64 + m * 16 + fr;
            *(u32x4*)(dummy + ((size_t)(u.pm & 15) * 256 + row) * 1024 + (u.pn & 3) * 256 + col) = pk8(acc[ai][bj][m][0] + acc[1][bj][m][0], acc[ai][bj][m][1] + acc[1][bj][m][1]); }
      }
    }
  }
};
struct DBranch {
  const Params& p; int K; StaticOrder S;
  DEV bool next(int i, Unit& u) const { u.aux = i % 3; return S.next(i / 3, u.pm, u.pn); }
  DEV const char* abase(const Unit& u) const { return u.aux == 0 ? p.ws + OFF_AQ : (u.aux == 1 ? (const char*)p.out + (size_t)64 * MiB : p.ws + OFF_MQ); }
  DEV unsigned arow(const Unit& u, int r) const { return (unsigned)(u.pm * 256 + r) * 1024u; }
  DEV const char* bbase(const Unit& u) const { return p.ws + OFF_WB + ((size_t)u.aux * 1024 + u.pn * 256) * 1024; }
  DEV void epi(const acc_t& acc, const Unit& u, int wr, int wc, int fr, int fq) const {
    const bf16_t* gates = WSP(bf16_t, OFF_GATES); bf16_t* merged = WSP(bf16_t, OFF_MERGED);
#pragma unroll
    for (int ai = 0; ai < 2; ++ai)
#pragma unroll
      for (int m = 0; m < 4; ++m) { const int row = u.pm * 256 + ai * 128 + wr * 64 + m * 16 + fr;
#pragma unroll
        for (int bj = 0; bj < 2; ++bj) {
          const int col = u.pn * 256 + wc * 64 + bj * 32 + 8 * fq;
          f32x4 g0, g1; unpk8(*(const u32x4*)(gates + (size_t)row * 3072 + u.aux * 1024 + col), g0, g1);
          f32x4 v0 = g0 * acc[ai][bj][m][0], v1 = g1 * acc[ai][bj][m][1];
          bf16_t* dst = merged + (size_t)row * 1024 + col;
          if (u.aux != 0) { f32x4 p0, p1; unpk8(*(const u32x4*)dst, p0, p1); v0 += p0; v1 += p1; }
          *(u32x4*)dst = pk8(v0, v1);
        } }
  }
};
struct DOut {
  const Params& p; int K; StaticOrder S;
  DEV bool next(int i, Unit& u) const { return S.next(i, u.pm, u.pn); }
  DEV const char* abase(const Unit&) const { return p.ws + OFF_MERGED; }
  DEV unsigned arow(const Unit& u, int r) const { return (unsigned)(u.pm * 256 + r) * 2048u; }
  DEV const char* bbase(const Unit& u) const { return p.ws + OFF_WO + (size_t)u.pn * 256 * 2048; }
  DEV void epi(const acc_t& acc, const Unit& u, int wr, int wc, int fr, int fq) const {
#pragma unroll
    for (int ai = 0; ai < 2; ++ai)
#pragma unroll
      for (int m = 0; m < 4; ++m) { const int row = u.pm * 256 + ai * 128 + wr * 64 + m * 16 + fr;
#pragma unroll
        for (int bj = 0; bj < 2; ++bj)
#pragma unroll
          for (int n = 0; n < 2; ++n) { const size_t o = (size_t)row * 1024 + u.pn * 256 + wc * 64 + bj * 32 + 8 * fq + 4 * n; *(f32x4*)(p.out + o) = *(const f32x4*)(p.x + o) + acc[ai][bj][m][n]; } }
  }
};
DEV bool moe_unit(const unsigned* cnt, int L, Unit& u) {
  int rt = L >> 2; u.pn = L & 3;
  for (int e = 0; e < 16; ++e) { const int ne = (int)cnt[e], te = (ne + 255) >> 8; if (rt < te) { u.pm = rt; u.aux = e; u.ne = ne; return true; } rt -= te; }
  return false;
}
struct DUp {
  const Params& p; int K;
  DEV bool next(int i, Unit& u) const { return moe_unit(WSP(unsigned, OFF_CNT), i * (int)gridDim.x + (int)blockIdx.x, u); }
  DEV const char* abase(const Unit&) const { return p.ws + OFF_HN; }
  DEV unsigned arow(const Unit& u, int r) const { const int rr = u.pm * 256 + r; return (unsigned)(WSP(int, OFF_LIST)[(size_t)u.aux * T + (rr < u.ne ? rr : u.ne - 1)] >> 1) * 2048u; }
  DEV const char* bbase(const Unit& u) const { return p.ws + OFF_W13 + ((size_t)u.aux * 1024 + u.pn * 256) * 2048; }
  DEV void epi(const acc_t& acc, const Unit& u, int wr, int wc, int fr, int fq) const {
    bf16_t* hid = WSP(bf16_t, OFF_HID); const int* le = WSP(int, OFF_LIST) + (size_t)u.aux * T; const float* cw = WSP(float, OFF_CW);
#pragma unroll
    for (int ai = 0; ai < 2; ++ai)
#pragma unroll
      for (int m = 0; m < 4; ++m) {
        const int rr = u.pm * 256 + ai * 128 + wr * 64 + m * 16 + fr;
        if (rr < u.ne) {
          const int ent = le[rr]; const float cwv = cw[ent]; f32x4 o[2];
#pragma unroll
          for (int n = 0; n < 2; ++n)
#pragma unroll
            for (int q = 0; q < 4; ++q) { const float v = acc[ai][0][m][n][q]; o[n][q] = v / (1.0f + __expf(-v)) * acc[ai][1][m][n][q] * cwv; }
          *(u32x4*)(hid + (size_t)ent * 512 + u.pn * 128 + wc * 32 + 8 * fq) = pk8(o[0], o[1]);
        }
      }
  }
};
struct DDown {
  const Params& p; int K;
  DEV bool next(int i, Unit& u) const { return moe_unit(WSP(unsigned, OFF_CNT), i * (int)gridDim.x + (int)blockIdx.x, u); }
  DEV const char* abase(const Unit&) const { return p.ws + OFF_HID; }
  DEV unsigned arow(const Unit& u, int r) const { const int rr = u.pm * 256 + r; return (unsigned)WSP(int, OFF_LIST)[(size_t)u.aux * T + (rr < u.ne ? rr : u.ne - 1)] * 1024u; }
  DEV const char* bbase(const Unit& u) const { return p.ws + OFF_W2 + ((size_t)u.aux * 1024 + u.pn * 256) * 1024; }
  DEV void epi(const acc_t& acc, const Unit& u, int wr, int wc, int fr, int fq) const {
    bf16_t* moe = WSP(bf16_t, OFF_MOE); const int* le = WSP(int, OFF_LIST) + (size_t)u.aux * T;
#pragma unroll
    for (int ai = 0; ai < 2; ++ai)
#pragma unroll
      for (int m = 0; m < 4; ++m) {
        const int rr = u.pm * 256 + ai * 128 + wr * 64 + m * 16 + fr;
        if (rr < u.ne) { const int ent = le[rr];
#pragma unroll
          for (int bj = 0; bj < 2; ++bj) *(u32x4*)(moe + (size_t)ent * 1024 + u.pn * 256 + wc * 64 + bj * 32 + 8 * fq) = pk8(acc[ai][bj][m][0], acc[ai][bj][m][1]); }
      }
  }
};
DEV void ph_gemm1(const Params& p, ldsb_t lds) {
  { DMemKV d{p, 1024}; gemm256(lds, d); }
  { DGemm1 d{p, 1024, {}}; d.S.init(T / 256, NIN_PAD / 256, gridDim.x, blockIdx.x); gemm256(lds, d); }
}
template <int MODE> DEV void ph_gates_probe(const Params& p, ldsb_t lds) { DGatesProbe<MODE> d{p, 1024, {}}; d.S.init(T / 256, 12, gridDim.x, blockIdx.x); gemm256(lds, d); }
DEV void ph_gates(const Params& p, ldsb_t lds) { DGates d{p, 1024, {}}; d.S.init(T / 256, 12, gridDim.x, blockIdx.x); gemm256(lds, d); }
DEV void ph_branch(const Params& p, ldsb_t lds) { DBranch d{p, 512, {}}; d.S.init(T / 256, 4, gridDim.x, blockIdx.x); gemm256(lds, d); }
DEV void ph_out(const Params& p, ldsb_t lds) { DOut d{p, 1024, {}}; d.S.init(T / 256, 4, gridDim.x, blockIdx.x); gemm256(lds, d); }
DEV void ph_up(const Params& p, ldsb_t lds) { DUp d{p, 1024}; gemm256(lds, d); }
DEV void ph_down(const Params& p, ldsb_t lds) { DDown d{p, 512}; gemm256(lds, d); }
typedef short v4i16_t __attribute__((ext_vector_type(4)));
template <int DH, int NKB, class KR, class VR, class MK>
DEV void attend16(const bf16_t* qrow, KR krow, VR vrow, MK mask, float sl2, char* vl, f32x4 (&o)[DH / 16], float& lse2) {
  static_assert(DH == 64 && NKB % 4 == 0, "gathered attention: head dim 64, key blocks in chunks of 4");
  const int lane = TIDX & 63, fr = lane & 15, fq = lane >> 4, lr = lane >> 3, lc = lane & 7;
  constexpr int KS = 2, STRIDE = 160, ND = 4, NPB = NKB / 2, VB = 4, NCH = NKB / 4;
  bf16x8 qf[KS];
#pragma unroll
  for (int s = 0; s < KS; ++s) qf[s] = *(const bf16x8*)(qrow + 32 * s + 8 * fq);
  f32x4 sc[NKB];
  char* kimg = vl; char* vimg = vl + 8192;
  const int kwoff = lr * 128 + (((lc ^ (lr >> 1)) & 7) << 4);
  const int swz = (fr >> 1) & 7;
  u32x4 kreg[2][8];
#pragma unroll
  for (int c = 0; c < 2; ++c)
#pragma unroll
    for (int i = 0; i < 8; ++i) kreg[c][i] = *(const u32x4*)(krow(c * 64 + 8 * i + lr) + lc * 8);
  u32x4 vreg[VB][4];
#pragma unroll
  for (int c = 0; c < NCH; ++c) {
#pragma unroll
    for (int i = 0; i < 8; ++i) { const int row = 8 * i + lr; *(u32x4*)(kimg + row * 128 + (((lc ^ (row >> 1)) & 7) << 4)) = kreg[c & 1][i]; }
    if (c + 2 < NCH) {
#pragma unroll
      for (int i = 0; i < 8; ++i) kreg[c & 1][i] = *(const u32x4*)(krow((c + 2) * 64 + 8 * i + lr) + lc * 8);
    }
    if (c == NCH - 1) {
#pragma unroll
      for (int j = 0; j < VB; ++j)
#pragma unroll
        for (int e = 0; e < 4; ++e) vreg[j][e] = *(const u32x4*)(vrow(j * 32 + 8 * e + lr) + lc * 8);
    }
#pragma unroll
    for (int kb = 0; kb < 4; ++kb) {
      f32x4 a = {0.f, 0.f, 0.f, 0.f};
#pragma unroll
      for (int s = 0; s < KS; ++s) { const bf16x8 kf = *(const bf16x8*)(kimg + (kb * 16 + fr) * 128 + (((4 * s + fq) ^ swz) << 4)); a = __builtin_amdgcn_mfma_f32_16x16x32_bf16(kf, qf[s], a, 0, 0, 0); }
      sc[4 * c + kb] = a;
    }
  }
  (void)kwoff;
  float mx = -INFINITY;
#pragma unroll
  for (int kb = 0; kb < NKB; ++kb)
#pragma unroll
    for (int i = 0; i < 4; ++i) { float v = sc[kb][i] * sl2; v = mask(kb * 16 + 4 * fq + i, fr) ? v : -INFINITY; sc[kb][i] = v; mx = fmaxf(mx, v); }
  mx = fmaxf(mx, __shfl_xor(mx, 16)); mx = fmaxf(mx, __shfl_xor(mx, 32));
  float l = 0.f;
#pragma unroll
  for (int kb = 0; kb < NKB; ++kb)
#pragma unroll
    for (int i = 0; i < 4; ++i) { const float pe = __builtin_amdgcn_exp2f(sc[kb][i] - mx); sc[kb][i] = pe; l += pe; }
  l += __shfl_xor(l, 16); l += __shfl_xor(l, 32);
#pragma unroll
  for (int db = 0; db < ND; ++db) o[db] = (f32x4){0.f, 0.f, 0.f, 0.f};
  typedef __attribute__((address_space(3))) v4i16_t* lds_v4p;
  const lds_v4p trb = (lds_v4p)(vimg + (4 * fq + (fr >> 2)) * STRIDE + (fr & 3) * 8);
#pragma unroll
  for (int pb0 = 0; pb0 < NPB; pb0 += VB) {
#pragma unroll
    for (int j = 0; j < VB; ++j) {
      const int pb = pb0 + j;
#pragma unroll
      for (int e = 0; e < 4; ++e) *(u32x4*)(vimg + (8 * e + lr) * STRIDE + lc * 16) = vreg[j][e];
      if (pb + VB < NPB) {
#pragma unroll
        for (int e = 0; e < 4; ++e) vreg[j][e] = *(const u32x4*)(vrow((pb + VB) * 32 + 8 * e + lr) + lc * 8);
      }
      u32x4 pw; pw.x = pk2(sc[2 * pb][0], sc[2 * pb][1]); pw.y = pk2(sc[2 * pb][2], sc[2 * pb][3]); pw.z = pk2(sc[2 * pb + 1][0], sc[2 * pb + 1][1]); pw.w = pk2(sc[2 * pb + 1][2], sc[2 * pb + 1][3]);
      const bf16x8 pf = __builtin_bit_cast(bf16x8, pw);
#pragma unroll
      for (int db = 0; db < ND; ++db) {
        const v4i16_t lo = __builtin_amdgcn_ds_read_tr16_b64_v4i16((lds_v4p)((__attribute__((address_space(3))) char*)trb + db * 32));
        const v4i16_t hi = __builtin_amdgcn_ds_read_tr16_b64_v4i16((lds_v4p)((__attribute__((address_space(3))) char*)trb + db * 32 + 16 * STRIDE));
        const bf16x8 vf = {lo[0], lo[1], lo[2], lo[3], hi[0], hi[1], hi[2], hi[3]};
        o[db] = __builtin_amdgcn_mfma_f32_16x16x32_bf16(vf, pf, o[db], 0, 0, 0);
      }
    }
  }
  const float inv = 1.0f / l;
#pragma unroll
  for (int db = 0; db < ND; ++db) o[db] *= inv;
  lse2 = mx + __builtin_amdgcn_logf(l);
}

template <int DH, int NKB, class MK>
DEV void attend16_sh(const bf16_t* qrow, const char* kt, const char* vt, MK mask, float sl2, f32x4 (&o)[DH / 16], float& lse2) {
  const int lane = TIDX & 63, fr = lane & 15, fq = lane >> 4;
  constexpr int KS = DH / 32, KST = DH * 2, VST = DH * 2 + 32, ND = DH / 16, NPB = (NKB + 1) / 2;
  bf16x8 qf[KS];
#pragma unroll
  for (int s = 0; s < KS; ++s) qf[s] = *(const bf16x8*)(qrow + 32 * s + 8 * fq);
  const int swz = DH == 64 ? ((fr >> 1) & 7) : fr;
  const char* kl = kt + fr * KST;
  f32x4 sc[2 * NPB];
#pragma unroll
  for (int kb = 0; kb < NKB; ++kb) {
    f32x4 a = {0.f, 0.f, 0.f, 0.f};
#pragma unroll
    for (int s = 0; s < KS; ++s) { const bf16x8 kf = *(const bf16x8*)(kl + kb * 16 * KST + (((4 * s + fq) ^ swz) << 4)); a = __builtin_amdgcn_mfma_f32_16x16x32_bf16(kf, qf[s], a, 0, 0, 0); }
    sc[kb] = a;
  }
  float mx = -INFINITY;
#pragma unroll
  for (int kb = 0; kb < NKB; ++kb)
#pragma unroll
    for (int i = 0; i < 4; ++i) { float v = sc[kb][i] * sl2; v = mask(kb * 16 + 4 * fq + i, fr) ? v : -INFINITY; sc[kb][i] = v; mx = fmaxf(mx, v); }
  mx = fmaxf(mx, __shfl_xor(mx, 16)); mx = fmaxf(mx, __shfl_xor(mx, 32));
  float l = 0.f;
#pragma unroll
  for (int kb = 0; kb < NKB; ++kb)
#pragma unroll
    for (int i = 0; i < 4; ++i) { const float pe = __builtin_amdgcn_exp2f(sc[kb][i] - mx); sc[kb][i] = pe; l += pe; }
  if (NKB & 1) sc[NKB] = (f32x4){0.f, 0.f, 0.f, 0.f};
  l += __shfl_xor(l, 16); l += __shfl_xor(l, 32);
#pragma unroll
  for (int db = 0; db < ND; ++db) o[db] = (f32x4){0.f, 0.f, 0.f, 0.f};
  typedef __attribute__((address_space(3))) v4i16_t* lds_v4p;
  typedef __attribute__((address_space(3))) char* lds_cp;
  const lds_cp trb = (lds_cp)(vt + (4 * fq + (fr >> 2)) * VST + (fr & 3) * 8);
#pragma unroll
  for (int pb = 0; pb < NPB; ++pb) {
    u32x4 pw; pw.x = pk2(sc[2 * pb][0], sc[2 * pb][1]); pw.y = pk2(sc[2 * pb][2], sc[2 * pb][3]); pw.z = pk2(sc[2 * pb + 1][0], sc[2 * pb + 1][1]); pw.w = pk2(sc[2 * pb + 1][2], sc[2 * pb + 1][3]);
    const bf16x8 pf = __builtin_bit_cast(bf16x8, pw);
#pragma unroll
    for (int db = 0; db < ND; ++db) {
      const v4i16_t lo = __builtin_amdgcn_ds_read_tr16_b64_v4i16((lds_v4p)(trb + pb * 32 * VST + db * 32));
      const v4i16_t hi = __builtin_amdgcn_ds_read_tr16_b64_v4i16((lds_v4p)(trb + pb * 32 * VST + db * 32 + 16 * VST));
      const bf16x8 vf = {lo[0], lo[1], lo[2], lo[3], hi[0], hi[1], hi[2], hi[3]};
      o[db] = __builtin_amdgcn_mfma_f32_16x16x32_bf16(vf, pf, o[db], 0, 0, 0);
    }
  }
  const float inv = 1.0f / l;
#pragma unroll
  for (int db = 0; db < ND; ++db) o[db] *= inv;
  lse2 = mx + __builtin_amdgcn_logf(l);
}
template <int DH, int NKB, class MK0, class MK1>
DEV void attend16_sh2(const bf16_t* q0, const bf16_t* q1, const char* kt0, const char* kt1, const char* vt0, const char* vt1, MK0 mask0, MK1 mask1, float sl2,
                      f32x4 (&o0)[DH / 16], f32x4 (&o1)[DH / 16], float& lse0, float& lse1) {
  const int lane = TIDX & 63, fr = lane & 15, fq = lane >> 4;
  constexpr int KS = DH / 32, KST = DH * 2, VST = DH * 2 + 32, ND = DH / 16, NPB = (NKB + 1) / 2;
  const bf16_t* qq[2] = {q0, q1}; const char* ktt[2] = {kt0, kt1}; const char* vtt[2] = {vt0, vt1};
  bf16x8 qf[2][KS];
#pragma unroll
  for (int t = 0; t < 2; ++t)
#pragma unroll
    for (int s = 0; s < KS; ++s) qf[t][s] = *(const bf16x8*)(qq[t] + 32 * s + 8 * fq);
  const int swz = DH == 64 ? ((fr >> 1) & 7) : fr;
  f32x4 sc[2][2 * NPB];
#pragma unroll
  for (int kb = 0; kb < NKB; ++kb)
#pragma unroll
    for (int t = 0; t < 2; ++t) {
      f32x4 a = {0.f, 0.f, 0.f, 0.f};
#pragma unroll
      for (int s = 0; s < KS; ++s) { const bf16x8 kf = *(const bf16x8*)(ktt[t] + fr * KST + kb * 16 * KST + (((4 * s + fq) ^ swz) << 4)); a = __builtin_amdgcn_mfma_f32_16x16x32_bf16(kf, qf[t][s], a, 0, 0, 0); }
      sc[t][kb] = a;
    }
  float mx[2] = {-INFINITY, -INFINITY};
#pragma unroll
  for (int kb = 0; kb < NKB; ++kb)
#pragma unroll
    for (int i = 0; i < 4; ++i) {
      float v0 = sc[0][kb][i] * sl2; v0 = mask0(kb * 16 + 4 * fq + i, fr) ? v0 : -INFINITY; sc[0][kb][i] = v0; mx[0] = fmaxf(mx[0], v0);
      float v1 = sc[1][kb][i] * sl2; v1 = mask1(kb * 16 + 4 * fq + i, fr) ? v1 : -INFINITY; sc[1][kb][i] = v1; mx[1] = fmaxf(mx[1], v1);
    }
#pragma unroll
  for (int t = 0; t < 2; ++t) { mx[t] = fmaxf(mx[t], __shfl_xor(mx[t], 16)); mx[t] = fmaxf(mx[t], __shfl_xor(mx[t], 32)); }
  float l[2] = {0.f, 0.f};
#pragma unroll
  for (int kb = 0; kb < NKB; ++kb)
#pragma unroll
    for (int i = 0; i < 4; ++i)
#pragma unroll
      for (int t = 0; t < 2; ++t) { const float pe = __builtin_amdgcn_exp2f(sc[t][kb][i] - mx[t]); sc[t][kb][i] = pe; l[t] += pe; }
  if (NKB & 1) { sc[0][NKB] = (f32x4){0.f, 0.f, 0.f, 0.f}; sc[1][NKB] = (f32x4){0.f, 0.f, 0.f, 0.f}; }
#pragma unroll
  for (int t = 0; t < 2; ++t) { l[t] += __shfl_xor(l[t], 16); l[t] += __shfl_xor(l[t], 32); }
#pragma unroll
  for (int db = 0; db < ND; ++db) { o0[db] = (f32x4){0.f, 0.f, 0.f, 0.f}; o1[db] = (f32x4){0.f, 0.f, 0.f, 0.f}; }
  typedef __attribute__((address_space(3))) v4i16_t* lds_v4p;
  typedef __attribute__((address_space(3))) char* lds_cp;
  const int troff = (4 * fq + (fr >> 2)) * VST + (fr & 3) * 8;
  const lds_cp trb0 = (lds_cp)(vtt[0] + troff), trb1 = (lds_cp)(vtt[1] + troff);
#pragma unroll
  for (int pb = 0; pb < NPB; ++pb) {
    u32x4 pw0, pw1;
    pw0.x = pk2(sc[0][2 * pb][0], sc[0][2 * pb][1]); pw0.y = pk2(sc[0][2 * pb][2], sc[0][2 * pb][3]); pw0.z = pk2(sc[0][2 * pb + 1][0], sc[0][2 * pb + 1][1]); pw0.w = pk2(sc[0][2 * pb + 1][2], sc[0][2 * pb + 1][3]);
    pw1.x = pk2(sc[1][2 * pb][0], sc[1][2 * pb][1]); pw1.y = pk2(sc[1][2 * pb][2], sc[1][2 * pb][3]); pw1.z = pk2(sc[1][2 * pb + 1][0], sc[1][2 * pb + 1][1]); pw1.w = pk2(sc[1][2 * pb + 1][2], sc[1][2 * pb + 1][3]);
    const bf16x8 pf0 = __builtin_bit_cast(bf16x8, pw0), pf1 = __builtin_bit_cast(bf16x8, pw1);
#pragma unroll
    for (int db = 0; db < ND; ++db) {
      const v4i16_t lo0 = __builtin_amdgcn_ds_read_tr16_b64_v4i16((lds_v4p)(trb0 + pb * 32 * VST + db * 32));
      const v4i16_t hi0 = __builtin_amdgcn_ds_read_tr16_b64_v4i16((lds_v4p)(trb0 + pb * 32 * VST + db * 32 + 16 * VST));
      const v4i16_t lo1 = __builtin_amdgcn_ds_read_tr16_b64_v4i16((lds_v4p)(trb1 + pb * 32 * VST + db * 32));
      const v4i16_t hi1 = __builtin_amdgcn_ds_read_tr16_b64_v4i16((lds_v4p)(trb1 + pb * 32 * VST + db * 32 + 16 * VST));
      const bf16x8 vf0 = {lo0[0], lo0[1], lo0[2], lo0[3], hi0[0], hi0[1], hi0[2], hi0[3]};
      const bf16x8 vf1 = {lo1[0], lo1[1], lo1[2], lo1[3], hi1[0], hi1[1], hi1[2], hi1[3]};
      o0[db] = __builtin_amdgcn_mfma_f32_16x16x32_bf16(vf0, pf0, o0[db], 0, 0, 0);
      o1[db] = __builtin_amdgcn_mfma_f32_16x16x32_bf16(vf1, pf1, o1[db], 0, 0, 0);
    }
  }
  const float inv0 = 1.0f / l[0], inv1 = 1.0f / l[1];
#pragma unroll
  for (int db = 0; db < ND; ++db) { o0[db] *= inv0; o1[db] *= inv1; }
  lse0 = mx[0] + __builtin_amdgcn_logf(l[0]); lse1 = mx[1] + __builtin_amdgcn_logf(l[1]);
}
constexpr float LOG2E = 1.4426950408889634f;
struct BUnit { int b, g, h, dsh, nsub, res, U0; };
DEV BUnit b_decode(int u) {
  BUnit r; const int x = u & 31, bgh = u >> 5; r.h = bgh & 7; const int bg = bgh >> 3; r.g = bg % 3; r.b = bg / 3;
  r.dsh = 2 * r.g; r.nsub = S >> r.dsh; const int cps = r.nsub >> 8; r.res = x / cps; r.U0 = (x % cps) * 256; return r;
}
constexpr int B_KROWS = 384, B_VROWS = 400, B_VOFF = B_KROWS * 128;
DEV void b_load(const Params& p, const BUnit& d, u32x4 (&kr)[6], u32x4 (&vr)[7]) {
  const int tid = TIDX;
  const size_t hoff = (size_t)(d.g * 8 + d.h) * 64;
  const bf16_t* kb_ = WSP(bf16_t, OFF_BK) + (size_t)d.b * S * 1536 + hoff;
  const bf16_t* vb_ = WSP(bf16_t, OFF_BV) + (size_t)d.b * S * 1536 + hoff;
#pragma unroll
  for (int i = 0; i < 6; ++i) { const int id = tid + NTH * i, row = id >> 3, ch = id & 7; int us = d.U0 - 128 + row; us = us < 0 ? 0 : (us >= d.nsub ? d.nsub - 1 : us);
    kr[i] = *(const u32x4*)(kb_ + (size_t)((us << d.dsh) + d.res) * 1536 + ch * 8); }
#pragma unroll
  for (int i = 0; i < 7; ++i) { int id = tid + NTH * i; id = id < B_VROWS * 8 ? id : B_VROWS * 8 - 1; const int row = id >> 3, ch = id & 7; int us = d.U0 - 128 + row; us = us < 0 ? 0 : (us >= d.nsub ? d.nsub - 1 : us);
    vr[i] = *(const u32x4*)(vb_ + (size_t)((us << d.dsh) + d.res) * 1536 + ch * 8); }
}
DEV void b_write(char* lds, const u32x4 (&kr)[6], const u32x4 (&vr)[7]) {
  const int tid = TIDX; char* kt = lds; char* vt = lds + B_VOFF;
#pragma unroll
  for (int i = 0; i < 6; ++i) { const int id = tid + NTH * i, row = id >> 3, ch = id & 7; *(u32x4*)(kt + row * 128 + (((ch ^ (row >> 1)) & 7) << 4)) = kr[i]; }
#pragma unroll
  for (int i = 0; i < 7; ++i) { const int id = tid + NTH * i; if (id < B_VROWS * 8) { const int row = id >> 3, ch = id & 7; *(u32x4*)(vt + row * 160 + ch * 16) = vr[i]; } }
}
DEV void b_compute(const Params& p, const BUnit& d, char* lds, bf16_t* dummy) {
  const int tid = TIDX, lane = tid & 63, wid = tid >> 6, fr = lane & 15, fq = lane >> 4;
  const size_t hoff = (size_t)(d.g * 8 + d.h) * 64;
  char* kt = lds; char* vt = lds + B_VOFF;
  const int uA = d.U0 + 16 * wid, uB = uA + 128;
  const int tqA = ((uA + fr) << d.dsh) + d.res, tqB = ((uB + fr) << d.dsh) + d.res;
  bf16_t* qA = WSP(bf16_t, OFF_BQ) + (size_t)(d.b * S + tqA) * 1536 + hoff;
  bf16_t* qB = WSP(bf16_t, OFF_BQ) + (size_t)(d.b * S + tqB) * 1536 + hoff;
  bf16_t* qoA = dummy ? dummy + ((qA - WSP(bf16_t, OFF_BQ)) & (8 * MiB - 1)) : qA;
  bf16_t* qoB = dummy ? dummy + ((qB - WSP(bf16_t, OFF_BQ)) & (8 * MiB - 1)) : qB;
  f32x4 oA[4], oB[4]; float lseA, lseB;
  attend16_sh2<64, 9>(qA, qB, kt + 16 * wid * 128, kt + 16 * (wid + 8) * 128, vt + 16 * wid * 160, vt + 16 * (wid + 8) * 160,
                      [&](int r, int c) { return r >= c && r <= 128 + c && (uA - 128 + r) >= 0; }, [&](int r, int c) { return r >= c && r <= 128 + c; }, 0.125f * LOG2E, oA, oB, lseA, lseB);
#pragma unroll
  for (int db = 0; db < 4; ++db) { *(u32x2*)(qoA + 16 * db + 4 * fq) = pk4(oA[db]); *(u32x2*)(qoB + 16 * db + 4 * fq) = pk4(oB[db]); }
  if (fq == 0 && !dummy) { float* lp = WSP(float, OFF_LSE) + d.g * 8 + d.h; lp[(size_t)(d.b * S + tqA) * 24] = lseA; lp[(size_t)(d.b * S + tqB) * 24] = lseB; }
}
DEV void ph_attn_b_blk(const Params& p, char* lds, bf16_t* dummy) {
  constexpr int NU = NB * 3 * 8 * 32;
  int u = blockIdx.x; if (u >= NU) return;
  u32x4 kr[6], vr[7];
  BUnit d = b_decode(u);
  b_load(p, d, kr, vr);
  for (;;) {
    b_write(lds, kr, vr);
    __syncthreads();
    const int un = u + gridDim.x; const bool more = un < NU;
    BUnit dn = d;
    if (more) { dn = b_decode(un); b_load(p, dn, kr, vr); }
    b_compute(p, d, lds, dummy);
    __syncthreads();
    if (!more) break;
    u = un; d = dn;
  }
}
DEV void unit_attn_m_blk(const Params& p, int u, char* lds, bf16_t* dummy = nullptr) {
  const int tid = TIDX, lane = tid & 63, wid = tid >> 6, fr = lane & 15, fq = lane >> 4;
  const int part = u & 15, h = (u >> 4) & 3, b = u >> 6;
  const bf16_t* kvb = WSP(bf16_t, OFF_KV) + (size_t)b * 256 * 1024 + h * 128;
  char* kt = lds; char* vt = lds + 65536;
#pragma unroll
  for (int hf = 0; hf < 2; ++hf) {
    u32x4 kr[4], vr[4];
#pragma unroll
    for (int i = 0; i < 4; ++i) { const int id = tid + NTH * (hf * 4 + i), row = id >> 4, ch = id & 15; kr[i] = *(const u32x4*)(kvb + (size_t)row * 1024 + ch * 8); vr[i] = *(const u32x4*)(kvb + (size_t)row * 1024 + 512 + ch * 8); }
#pragma unroll
    for (int i = 0; i < 4; ++i) { const int id = tid + NTH * (hf * 4 + i), row = id >> 4, ch = id & 15; *(u32x4*)(kt + row * 256 + (((ch ^ row) & 15) << 4)) = kr[i]; *(u32x4*)(vt + row * 288 + ch * 16) = vr[i]; }
  }
  __syncthreads();
#pragma unroll 1
  for (int tl = wid; tl < 32; tl += NWV) {
    const int t0 = b * S + part * 512 + tl * 16;
    bf16_t* q = WSP(bf16_t, OFF_MQ) + (size_t)(t0 + fr) * 512 + h * 128;
    bf16_t* qo = dummy ? dummy + ((q - WSP(bf16_t, OFF_MQ)) & (8 * MiB - 1)) : q;
    f32x4 o[8]; float lse;
    attend16_sh<128, 16>(q, kt, vt, [&](int, int) { return true; }, 0.08838834764831845f * LOG2E, o, lse);
#pragma unroll
    for (int db = 0; db < 8; ++db) *(u32x2*)(qo + 16 * db + 4 * fq) = pk4(o[db]);
  }
  __syncthreads();
}
DEV void ph_attn_blk(const Params& p, char* lds, bf16_t* dummy = nullptr) {
  ph_attn_b_blk(p, lds, dummy);
  for (int u = blockIdx.x; u < NB * 4 * 16; u += gridDim.x) unit_attn_m_blk(p, u, lds, dummy);
}

DEV void unit_attn_a4(const Params& p, int u, char* vl, bf16_t* dummy = nullptr) {
  const int lane = TIDX & 63, fr = lane & 15, fq = lane >> 4, lr = lane >> 3, lc = lane & 7;
  const int kvh = u & 1, row0 = (u >> 1) * 4, b = row0 / S, t0 = row0 % S;
  const int myt = fr >> 2;
  const int cntc = (t0 + myt + 1) < 256 ? (t0 + myt + 1) : 256;
  bf16_t* q = WSP(bf16_t, OFF_AQ) + (size_t)(row0 + myt) * 512 + (kvh * 4 + (fr & 3)) * 64;
  unsigned short* sl = (unsigned short*)(vl + 13312);
#pragma unroll
  for (int ti = 0; ti < 4; ++ti) {
    const int cnt = (t0 + ti + 1) < 256 ? (t0 + ti + 1) : 256;
    u32x2 sv = *(const u32x2*)(WSP(unsigned short, OFF_SEL) + (size_t)(row0 + ti) * 256 + lane * 4);
    const int k0 = lane * 4;
    sv.x = (k0 < cnt ? sv.x & 0xFFFFu : 0u) | (k0 + 1 < cnt ? sv.x & 0xFFFF0000u : 0u);
    sv.y = (k0 + 2 < cnt ? sv.y & 0xFFFFu : 0u) | (k0 + 3 < cnt ? sv.y & 0xFFFF0000u : 0u);
    *(u32x2*)(vl + 13312 + ti * 512 + lane * 8) = sv;
  }
  const bf16_t* kb_ = WSP(bf16_t, OFF_AK) + (size_t)b * S * 128 + kvh * 64;
  const bf16_t* vb_ = WSP(bf16_t, OFF_AV) + (size_t)b * S * 128 + kvh * 64;
  bf16_t* qo = dummy ? dummy + ((q - WSP(bf16_t, OFF_AQ)) & (8 * MiB - 1)) : q;
  constexpr int NKB = 16, STRIDE = 160;
  bf16x8 qf[2];
#pragma unroll
  for (int s = 0; s < 2; ++s) qf[s] = *(const bf16x8*)(q + 32 * s + 8 * fq);
  char* kimg = vl; char* vimg = vl + 8192;
  const int swz = (fr >> 1) & 7;
  f32x4 sc[NKB];
#pragma unroll
  for (int kb = 0; kb < NKB; ++kb) sc[kb] = (f32x4){0.f, 0.f, 0.f, 0.f};
  u32x4 kreg[2][8];
#pragma unroll
  for (int c = 0; c < 2; ++c)
#pragma unroll
    for (int i = 0; i < 8; ++i) kreg[c][i] = *(const u32x4*)(kb_ + (size_t)sl[c * 64 + 8 * i + lr] * 128 + lc * 8);
#pragma unroll
  for (int cc = 0; cc < 16; ++cc) {
    const int ti = cc >> 2, c = cc & 3;
#pragma unroll
    for (int i = 0; i < 8; ++i) { const int row = 8 * i + lr; *(u32x4*)(kimg + row * 128 + (((lc ^ (row >> 1)) & 7) << 4)) = kreg[cc & 1][i]; }
    if (cc + 2 < 16) {
      const int t2 = (cc + 2) >> 2, c2 = (cc + 2) & 3;
#pragma unroll
      for (int i = 0; i < 8; ++i) kreg[cc & 1][i] = *(const u32x4*)(kb_ + (size_t)sl[t2 * 256 + c2 * 64 + 8 * i + lr] * 128 + lc * 8);
    }
#pragma unroll
    for (int kb = 0; kb < 4; ++kb) {
      f32x4 a = {0.f, 0.f, 0.f, 0.f};
#pragma unroll
      for (int s = 0; s < 2; ++s) { const bf16x8 kf = *(const bf16x8*)(kimg + (kb * 16 + fr) * 128 + (((4 * s + fq) ^ swz) << 4)); a = __builtin_amdgcn_mfma_f32_16x16x32_bf16(kf, qf[s], a, 0, 0, 0); }
      sc[4 * c + kb] = (myt == ti) ? a : sc[4 * c + kb];
    }
  }
  const float sl2 = 0.125f * LOG2E;
  float mx = -INFINITY;
#pragma unroll
  for (int kb = 0; kb < NKB; ++kb)
#pragma unroll
    for (int i = 0; i < 4; ++i) { float v = sc[kb][i] * sl2; v = (kb * 16 + 4 * fq + i) < cntc ? v : -INFINITY; sc[kb][i] = v; mx = fmaxf(mx, v); }
  mx = fmaxf(mx, __shfl_xor(mx, 16)); mx = fmaxf(mx, __shfl_xor(mx, 32));
  float l = 0.f;
#pragma unroll
  for (int kb = 0; kb < NKB; ++kb)
#pragma unroll
    for (int i = 0; i < 4; ++i) { const float pe = __builtin_amdgcn_exp2f(sc[kb][i] - mx); sc[kb][i] = pe; l += pe; }
  l += __shfl_xor(l, 16); l += __shfl_xor(l, 32);
  const float inv = 1.0f / l;
  bf16x8 pf[8];
#pragma unroll
  for (int pb = 0; pb < 8; ++pb) { u32x4 pw; pw.x = pk2(sc[2 * pb][0], sc[2 * pb][1]); pw.y = pk2(sc[2 * pb][2], sc[2 * pb][3]); pw.z = pk2(sc[2 * pb + 1][0], sc[2 * pb + 1][1]); pw.w = pk2(sc[2 * pb + 1][2], sc[2 * pb + 1][3]);
    pf[pb] = __builtin_bit_cast(bf16x8, pw); }
  typedef __attribute__((address_space(3))) v4i16_t* lds_v4p;
  const lds_v4p trb = (lds_v4p)(vimg + (4 * fq + (fr >> 2)) * STRIDE + (fr & 3) * 8);
  u32x4 vreg[4][4];
#pragma unroll
  for (int j = 0; j < 4; ++j)
#pragma unroll
    for (int e = 0; e < 4; ++e) vreg[j][e] = *(const u32x4*)(vb_ + (size_t)sl[j * 32 + 8 * e + lr] * 128 + lc * 8);
  f32x4 o[4];
#pragma unroll
  for (int pp = 0; pp < 32; ++pp) {
    const int ti = pp >> 3, pb = pp & 7;
    if (pb == 0) {
#pragma unroll
      for (int db = 0; db < 4; ++db) o[db] = (f32x4){0.f, 0.f, 0.f, 0.f};
    }
#pragma unroll
    for (int e = 0; e < 4; ++e) *(u32x4*)(vimg + (8 * e + lr) * STRIDE + lc * 16) = vreg[pp & 3][e];
    if (pp + 4 < 32) {
      const int t2 = (pp + 4) >> 3, p2 = (pp + 4) & 7;
#pragma unroll
      for (int e = 0; e < 4; ++e) vreg[pp & 3][e] = *(const u32x4*)(vb_ + (size_t)sl[t2 * 256 + p2 * 32 + 8 * e + lr] * 128 + lc * 8);
    }
#pragma unroll
    for (int db = 0; db < 4; ++db) {
      const v4i16_t lo = __builtin_amdgcn_ds_read_tr16_b64_v4i16((lds_v4p)((__attribute__((address_space(3))) char*)trb + db * 32));
      const v4i16_t hi = __builtin_amdgcn_ds_read_tr16_b64_v4i16((lds_v4p)((__attribute__((address_space(3))) char*)trb + db * 32 + 16 * STRIDE));
      const bf16x8 vf = {lo[0], lo[1], lo[2], lo[3], hi[0], hi[1], hi[2], hi[3]};
      o[db] = __builtin_amdgcn_mfma_f32_16x16x32_bf16(vf, pf[pb], o[db], 0, 0, 0);
    }
    if (pb == 7 && myt == ti) {
#pragma unroll
      for (int db = 0; db < 4; ++db) *(u32x2*)(qo + 16 * db + 4 * fq) = pk4(o[db] * inv);
    }
  }
}
DEV void ph_mergeb(const Params& p) {
  const bf16_t* og = WSP(bf16_t, OFF_BQ); const float* lse = WSP(float, OFF_LSE); bf16_t* yb = ((bf16_t*)p.out + (size_t)32 * MiB);
  for (int it = blockIdx.x * NTH + TIDX; it < T * 64; it += gridDim.x * NTH) {
    const int ch = it & 7, h = (it >> 3) & 7, row = it >> 6;
    const float l0 = lse[(size_t)row * 24 + h], l1 = lse[(size_t)row * 24 + 8 + h], l2 = lse[(size_t)row * 24 + 16 + h];
    const float mx = fmaxf(l0, fmaxf(l1, l2));
    float a0 = __builtin_amdgcn_exp2f(l0 - mx), a1 = __builtin_amdgcn_exp2f(l1 - mx), a2 = __builtin_amdgcn_exp2f(l2 - mx);
    const float inv = 1.0f / (a0 + a1 + a2); a0 *= inv; a1 *= inv; a2 *= inv;
    const bf16_t* src = og + (size_t)row * 1536 + h * 64 + ch * 8;
    const u32x4 v0 = *(const u32x4*)src, v1 = *(const u32x4*)(src + 512), v2 = *(const u32x4*)(src + 1024);
    u32x4 r;
#pragma unroll
    for (int e = 0; e < 4; ++e) {
      const float lo = a0 * __uint_as_float(v0[e] << 16) + a1 * __uint_as_float(v1[e] << 16) + a2 * __uint_as_float(v2[e] << 16);
      const float hi = a0 * __uint_as_float(v0[e] & 0xFFFF0000u) + a1 * __uint_as_float(v1[e] & 0xFFFF0000u) + a2 * __uint_as_float(v2[e] & 0xFFFF0000u);
      r[e] = pk2(lo, hi);
    }
    *(u32x4*)(yb + (size_t)row * 512 + h * 64 + ch * 8) = r;
  }
}

DEV float key2f(unsigned key) { return __uint_as_float((key & 0x80000000u) ? (key & 0x7FFFFFFFu) : ~key); }
typedef _Float16 h2_t __attribute__((ext_vector_type(2)));
typedef __fp16 hh2_t __attribute__((ext_vector_type(2)));
typedef _Float16 h8_t __attribute__((ext_vector_type(8)));
DEV unsigned pkrelu(float a, float b) {
  const hh2_t r = __builtin_amdgcn_cvt_pkrtz(a, b); h2_t v = __builtin_bit_cast(h2_t, r);
  const h2_t z = {(_Float16)0, (_Float16)0}; v = __builtin_elementwise_max(v, z); return __builtin_bit_cast(unsigned, v);
}
template <int PASS>
DEV void topk_pass(const bf16_t* ikb, unsigned short* selb, int t0, int qt, const bf16x8 (&af)[8][2], const h8_t (&wop)[2][2], unsigned* hist, int* st,
                   const float (&flo)[2], const float (&fhi)[2], const int (&exc)[2], const int (&loff)[2]) {
  const int lane = TIDX & 63, wid = TIDX >> 6, kx = lane & 15, q4 = lane >> 4;
  const int nslab = 2 * qt + 2;
  auto process = [&](int slab, const bf16x8& kf0, const bf16x8& kf1) {
    const bool diag = slab >= 2 * qt;
    f32x4 a[8];
#pragma unroll
    for (int mt = 0; mt < 8; ++mt) {
      a[mt] = (f32x4){0.f, 0.f, 0.f, 0.f};
      a[mt] = __builtin_amdgcn_mfma_f32_16x16x32_bf16(af[mt][0], kf0, a[mt], 0, 0, 0);
    }
#pragma unroll
    for (int mt = 0; mt < 8; ++mt) a[mt] = __builtin_amdgcn_mfma_f32_16x16x32_bf16(af[mt][1], kf1, a[mt], 0, 0, 0);
    f32x4 c2[2];
#pragma unroll
    for (int g2 = 0; g2 < 2; ++g2) {
      c2[g2] = (f32x4){0.f, 0.f, 0.f, 0.f};
#pragma unroll
      for (int pp = 0; pp < 2; ++pp) {
        const int m0 = 4 * g2 + 2 * pp;
        u32x4 pw; pw.x = pkrelu(a[m0][0], a[m0][1]); pw.y = pkrelu(a[m0][2], a[m0][3]); pw.z = pkrelu(a[m0 + 1][0], a[m0 + 1][1]); pw.w = pkrelu(a[m0 + 1][2], a[m0 + 1][3]);
        c2[g2] = __builtin_amdgcn_mfma_f32_16x16x32_f16(__builtin_bit_cast(h8_t, pw), wop[g2][pp], c2[g2], 0, 0, 0);
      }
    }
    const int key0 = slab * 16 + 4 * q4;
#pragma unroll
    for (int g2 = 0; g2 < 2; ++g2) {
      const int row = 16 * g2 + kx;
      float sc[4];
#pragma unroll
      for (int i = 0; i < 4; ++i) sc[i] = (diag && key0 + i > t0 + row) ? -INFINITY : c2[g2][i] + 0.0f;
      if (PASS == 0) {
#pragma unroll
        for (int i = 0; i < 4; ++i) { const unsigned u = __float_as_uint(sc[i]); atomicAdd(&hist[row * 512 + (u >> 23)], 1u << ((u >> 18) & 16u)); }
      } else if (PASS == 1) {
#pragma unroll
        for (int i = 0; i < 4; ++i)
          if (sc[i] >= flo[g2] && sc[i] < fhi[g2]) {
            const unsigned u = __float_as_uint(sc[i]);
            const unsigned fine = ((u ^ ((unsigned)((int)u >> 31) | 0x80000000u)) >> 12) & 1023u;
            atomicAdd(&hist[row * 512 + (fine >> 1)], 1u << ((fine & 1u) * 16));
          }
      } else if (PASS == 2) {
        int pos[4];
#pragma unroll
        for (int i = 0; i < 4; ++i) {
          const bool above = sc[i] >= fhi[g2], tie = !above && sc[i] >= flo[g2];
          pos[i] = -1;
          if (above || (tie && !exc[g2])) pos[i] = atomicAdd(&st[192 + row], 1);
          else if (tie) atomicOr(&hist[row * 256 + ((key0 + i) >> 5)], 1u << ((key0 + i) & 31));
        }
#pragma unroll
        for (int i = 0; i < 4; ++i) if (pos[i] >= 0) selb[(size_t)(t0 + row) * 256 + pos[i]] = (unsigned short)(key0 + i);
      } else {
        int pos[4];
#pragma unroll
        for (int i = 0; i < 4; ++i) {
          pos[i] = -1;
          if (sc[i] >= fhi[g2]) pos[i] = atomicAdd(&st[192 + row], 1);
          else if (sc[i] >= flo[g2]) {
            const unsigned u = __float_as_uint(sc[i]);
            const unsigned fine = ((u ^ ((unsigned)((int)u >> 31) | 0x80000000u)) >> 12) & 1023u;
            atomicAdd(&hist[row * 512 + (fine >> 1)], 1u << ((fine & 1u) * 16));
            const int lp = atomicAdd(&st[224 + row], 1);
            hist[16384 + loff[g2] + lp] = (fine << 13) | (unsigned)(key0 + i);
          }
        }
#pragma unroll
        for (int i = 0; i < 4; ++i) if (pos[i] >= 0) selb[(size_t)(t0 + row) * 256 + pos[i]] = (unsigned short)(key0 + i);
      }
    }
  };
  const bf16_t* kbase = ikb + (size_t)kx * 64 + 16 * q4;
  bf16x8 kq0[4], kq1[4];
#pragma unroll
  for (int j = 0; j < 4; ++j) { int s2 = wid + j * NWV; s2 = s2 < nslab ? s2 : wid; const bf16_t* kp = kbase + (size_t)s2 * 1024; kq0[j] = *(const bf16x8*)kp; kq1[j] = *(const bf16x8*)(kp + 8); }
  for (int slab = wid; slab < nslab; slab += 4 * NWV) {
#pragma unroll
    for (int j = 0; j < 4; ++j) {
      const int sj = slab + j * NWV;
      if (sj < nslab) process(sj, kq0[j], kq1[j]);
      int s2 = sj + 4 * NWV; s2 = s2 < nslab ? s2 : wid; const bf16_t* kp = kbase + (size_t)s2 * 1024; kq0[j] = *(const bf16x8*)kp; kq1[j] = *(const bf16x8*)(kp + 8);
    }
  }
}
DEV void topk_scan(unsigned* hist, int* st, int level) {
  const int lane = TIDX & 63, wid = TIDX >> 6;
  for (int i = 0; i < 4; ++i) {
    const int row = wid * 4 + i;
    const int k = level == 0 ? st[row] : st[64 + row];
    const bool rev = level == 0 && lane < 32;
    const int wbase = level == 0 ? (lane >= 32 ? lane * 8 - 256 : 504 - lane * 8) : lane * 8;
    const u32x4 w0 = *(const u32x4*)(hist + row * 512 + wbase), w1 = *(const u32x4*)(hist + row * 512 + wbase + 4);
    int c[16];
#pragma unroll
    for (int j = 0; j < 4; ++j) { c[2 * j] = (int)(w0[j] & 0xFFFFu); c[2 * j + 1] = (int)(w0[j] >> 16); c[8 + 2 * j] = (int)(w1[j] & 0xFFFFu); c[9 + 2 * j] = (int)(w1[j] >> 16); }
    if (rev) {
#pragma unroll
      for (int j = 0; j < 8; ++j) { const int t = c[j]; c[j] = c[15 - j]; c[15 - j] = t; }
    }
    int tot = 0;
#pragma unroll
    for (int j = 0; j < 16; ++j) tot += c[j];
    int v = tot;
#pragma unroll
    for (int off = 1; off < 64; off <<= 1) { const int t = __shfl_down(v, off); if (lane + off < 64) v += t; }
    const int excl = v - tot;
    if (excl < k && k <= v) {
      int cum = excl, bsel = 0, rsel = 0, csel = 0; bool found = false;
#pragma unroll
      for (int j = 15; j >= 0; --j) { if (!found && cum + c[j] >= k) { bsel = lane * 16 + j; rsel = k - cum; csel = c[j]; found = true; } cum += c[j]; }
      if (level == 0) { st[32 + row] = bsel; st[64 + row] = rsel; st[288 + row] = csel; }
      else { st[96 + row] = (st[32 + row] << 10) | bsel; st[128 + row] = csel > rsel ? 1 : 0; st[160 + row] = rsel; }
    }
  }
}
DEV void topk_unit(const Params& p, int b, int qt, char* lds) {
  const int tid = TIDX, lane = tid & 63, wid = tid >> 6, kx = lane & 15, q4 = lane >> 4;
  const int t0 = qt * 32; const size_t rb = (size_t)b * S;
  unsigned* hist = (unsigned*)lds; int* st = (int*)(lds + 131072);
  const bf16_t* iq = WSP(bf16_t, OFF_IQ); const bf16_t* ikb = WSP(bf16_t, OFF_IK) + rb * 64; const float* iw = WSP(float, OFF_IW);
  unsigned short* selb = WSP(unsigned short, OFF_SEL) + rb * 256;
  bf16x8 af[8][2];
#pragma unroll
  for (int mt = 0; mt < 8; ++mt) {
    const bf16_t* ap = iq + ((rb + t0 + 4 * mt + (kx >> 2)) * 4 + (kx & 3)) * 64 + 16 * q4;
    af[mt][0] = *(const bf16x8*)ap; af[mt][1] = *(const bf16x8*)(ap + 8);
  }
  h8_t wop[2][2];
#pragma unroll
  for (int g2 = 0; g2 < 2; ++g2) {
    const f32x4 w = *(const f32x4*)(iw + (rb + t0 + 16 * g2 + kx) * 4);
    const hh2_t w01 = __builtin_amdgcn_cvt_pkrtz(w[0], w[1]), w23 = __builtin_amdgcn_cvt_pkrtz(w[2], w[3]);
    const unsigned u01 = __builtin_bit_cast(unsigned, w01), u23 = __builtin_bit_cast(unsigned, w23);
    const bool mine = (kx & 3) == q4;
#pragma unroll
    for (int pp = 0; pp < 2; ++pp) {
      const bool inpair = mine && ((kx >> 3) == pp); const bool hi = (kx >> 2) & 1;
      u32x4 o; o.x = (inpair && !hi) ? u01 : 0u; o.y = (inpair && !hi) ? u23 : 0u; o.z = (inpair && hi) ? u01 : 0u; o.w = (inpair && hi) ? u23 : 0u;
      wop[g2][pp] = __builtin_bit_cast(h8_t, o);
    }
  }
  const u32x4 z4 = {0u, 0u, 0u, 0u};
#pragma unroll
  for (int i = 0; i < 8; ++i) *(u32x4*)(lds + (i * NTH + tid) * 16) = z4;
  if (tid < 32) { const int n = t0 + tid + 1; st[tid] = n < 256 ? n : 256; st[192 + tid] = 0; st[224 + tid] = 0; }
  if (tid == 32) st[256] = 0;
  __syncthreads();
  float flo[2] = {0.f, 0.f}, fhi[2] = {0.f, 0.f}; int exc[2] = {0, 0}, loff[2] = {0, 0};
  topk_pass<0>(ikb, selb, t0, qt, af, wop, hist, st, flo, fhi, exc, loff);
  __syncthreads();
  topk_scan(hist, st, 0);
  __syncthreads();
  if (tid < 64) {
    const int c0 = tid < 32 ? st[288 + tid] : 0; int v = c0;
#pragma unroll
    for (int off = 1; off < 32; off <<= 1) { const int t = __shfl_up(v, off); if (lane >= off) v += t; }
    if (tid < 32) st[320 + tid] = v - c0;
    if (tid == 31) st[256] = v > 16384 ? 1 : 0;
  }
  __syncthreads();
  const bool fallback = st[256] != 0;
#pragma unroll
  for (int i = 0; i < 8; ++i) *(u32x4*)(lds + (i * NTH + tid) * 16) = z4;
#pragma unroll
  for (int g2 = 0; g2 < 2; ++g2) { loff[g2] = st[320 + 16 * g2 + kx]; const unsigned b0 = (unsigned)st[32 + 16 * g2 + kx]; flo[g2] = key2f(b0 << 22); fhi[g2] = b0 >= 1023u ? INFINITY : key2f((b0 + 1u) << 22); }
  __syncthreads();
  if (!fallback) {
    topk_pass<3>(ikb, selb, t0, qt, af, wop, hist, st, flo, fhi, exc, loff);
    __syncthreads();
    topk_scan(hist, st, 1);
    __syncthreads();
#pragma unroll
    for (int i = 0; i < 4; ++i) *(u32x4*)(lds + (i * NTH + tid) * 16) = z4;
    __syncthreads();
    for (int i = 0; i < 4; ++i) {
      const int row = wid * 4 + i, n = st[224 + row], b1 = st[96 + row] & 1023, ex = st[128 + row];
      for (int e = lane; e < n; e += 64) {
        const unsigned w = hist[16384 + st[320 + row] + e]; const int fine = (int)(w >> 13), key = (int)(w & 8191u);
        if (fine > b1 || (fine == b1 && !ex)) { const int pos = atomicAdd(&st[192 + row], 1); selb[(size_t)(t0 + row) * 256 + pos] = (unsigned short)key; }
        else if (fine == b1) atomicOr(&hist[row * 256 + (key >> 5)], 1u << (key & 31));
      }
    }
  } else {
    topk_pass<1>(ikb, selb, t0, qt, af, wop, hist, st, flo, fhi, exc, loff);
    __syncthreads();
    topk_scan(hist, st, 1);
    __syncthreads();
#pragma unroll
    for (int i = 0; i < 4; ++i) *(u32x4*)(lds + (i * NTH + tid) * 16) = z4;
#pragma unroll
    for (int g2 = 0; g2 < 2; ++g2) { const unsigned T20 = (unsigned)st[96 + 16 * g2 + kx]; flo[g2] = key2f(T20 << 12); fhi[g2] = T20 >= 0xFFFFFu ? INFINITY : key2f((T20 + 1u) << 12); exc[g2] = st[128 + 16 * g2 + kx]; }
    __syncthreads();
    topk_pass<2>(ikb, selb, t0, qt, af, wop, hist, st, flo, fhi, exc, loff);
  }
  __syncthreads();
  for (int i = 0; i < 4; ++i) {
    const int row = wid * 4 + i;
    if (st[128 + row]) {
      const int r1 = st[160 + row], base = st[row] - r1;
      const u32x4 w = *(const u32x4*)(hist + row * 256 + lane * 4);
      const int pc = __popc(w.x) + __popc(w.y) + __popc(w.z) + __popc(w.w);
      int v = pc;
#pragma unroll
      for (int off = 1; off < 64; off <<= 1) { const int t = __shfl_up(v, off); if (lane >= off) v += t; }
      int rank = v - pc;
#pragma unroll
      for (int j = 0; j < 4; ++j) { unsigned ww = w[j];
        while (ww && rank < r1) { const int bit = __ffs((int)ww) - 1; selb[(size_t)(t0 + row) * 256 + base + rank] = (unsigned short)((lane * 4 + j) * 32 + bit); ++rank; ww &= ww - 1u; } }
    }
  }
  __syncthreads();
}
DEV void ph_topk(const Params& p, char* lds) {
  for (int i = blockIdx.x; i < 512; i += gridDim.x) {
    topk_unit(p, i & 3, i >> 2, lds);
    const int j = 1023 - i;
    topk_unit(p, j & 3, j >> 2, lds);
  }
}


#define XB_TMO      128
#define XB_XCNT(j)  (256  + 64 * (j))
#define XB_XSUB(j)  (1280 + 64 * (j))
#define XB_XGEN(j)  (2304 + 64 * (j))
#define XB_TOP      3328
#define XB_TOPGEN   3392
#define XCD_BAR_WORDS 3456
#define XB_SPIN_CAP (1u << 18)
#define LAS __attribute__((address_space(3)))
__device__ __forceinline__ unsigned xb_ld(unsigned* p)              { return __hip_atomic_load(p, __ATOMIC_RELAXED, __HIP_MEMORY_SCOPE_AGENT); }
__device__ __forceinline__ unsigned xb_add(unsigned* p, unsigned v) { return __hip_atomic_fetch_add(p, v, __ATOMIC_RELAXED, __HIP_MEMORY_SCOPE_AGENT); }
__device__ __forceinline__ unsigned xb_xcc_id() { return (unsigned)__builtin_amdgcn_s_getreg((3 << 11) | 20) & 0xFu; }
#define XB_SPIN(cond, bar) do { unsigned _sp = 0; while (cond) { __builtin_amdgcn_s_sleep(1); \
    if ((++_sp & 255u) == 0u) { if (xb_ld(&(bar)[XB_TMO])) break; if (_sp > XB_SPIN_CAP) { atomicAdd(&(bar)[XB_TMO], 1u); break; } } } } while (0)
struct XcdBarrier { unsigned* bar; unsigned x; volatile LAS unsigned* st; };
__device__ __forceinline__ XcdBarrier xcd_barrier_post(unsigned* bar, volatile LAS unsigned* st) {
    XcdBarrier b; b.bar = bar; b.x = xb_xcc_id(); b.st = st;
    if (threadIdx.x == 0) (void)xb_add(&bar[XB_XCNT(b.x)], 1u);
    return b;
}
__device__ __forceinline__ void xcd_barrier_complete(unsigned* bar, unsigned x, unsigned& nloc, unsigned& nx) {
    const unsigned G = gridDim.x * gridDim.y * gridDim.z;
    unsigned sum, cnt, mine, sp = 0u;
    for (;;) {
        sum = 0u; cnt = 0u; mine = 0u;
#pragma unroll
        for (unsigned j = 0; j < 16; ++j) { const unsigned c = xb_ld(&bar[XB_XCNT(j)]); sum += c; cnt += (c > 0u) ? 1u : 0u; mine = (j == x) ? c : mine; }
        if (sum == G) break;
        __builtin_amdgcn_s_sleep(1);
        if ((++sp & 255u) == 0u) { if (xb_ld(&bar[XB_TMO])) break; if (sp > XB_SPIN_CAP) { atomicAdd(&bar[XB_TMO], 1u); break; } }
    }
    nloc = mine > 0u ? mine : 1u; nx = cnt > 0u ? cnt : 1u;
}
__device__ __forceinline__ void xcd_barrier(const XcdBarrier& b) {
    asm volatile("s_waitcnt vmcnt(0)" ::: "memory");
    __syncthreads();
    if (threadIdx.x == 0) {
        unsigned* bar = b.bar;
        __builtin_amdgcn_s_waitcnt(0);
        unsigned nloc = b.st[0], nx = b.st[1];
        if (nloc == 0u) { xcd_barrier_complete(bar, b.x, nloc, nx); b.st[0] = nloc; b.st[1] = nx; }
        const unsigned old = xb_add(&bar[XB_XSUB(b.x)], 1u);
        const unsigned gen = old / nloc;
        if (old + 1u == (gen + 1u) * nloc) {
            __builtin_amdgcn_fence(__ATOMIC_RELEASE, "agent");
            asm volatile("s_waitcnt vmcnt(0)" ::: "memory");
            const unsigned og = xb_add(&bar[XB_TOP], 1u);
            const unsigned tg = og / nx;
            if (og + 1u == (tg + 1u) * nx) xb_add(&bar[XB_TOPGEN], 1u);
            else XB_SPIN(xb_ld(&bar[XB_TOPGEN]) == tg, bar);
            __builtin_amdgcn_fence(__ATOMIC_ACQUIRE, "agent");
            xb_add(&bar[XB_XGEN(b.x)], 1u);
            asm volatile("s_waitcnt vmcnt(0)" ::: "memory");
        } else {
            XB_SPIN(xb_ld(&bar[XB_XGEN(b.x)]) == gen, bar);
            __builtin_amdgcn_fence(__ATOMIC_ACQUIRE, "agent");
            asm volatile("s_waitcnt vmcnt(0)" ::: "memory");
        }
    }
    __syncthreads();
}

DEV void ph_route(const Params& p, char* lds, bool dry = false) { for (int blk = blockIdx.x; blk < T / 128; blk += gridDim.x) route_block(p, blk, lds, dry); }
DEV void ph_attn_a(const Params& p, char* lds, bf16_t* dummy = nullptr) {
  const int wid = TIDX >> 6; char* vl = lds + wid * 15360;
  for (int u = blockIdx.x * NWV + wid; u < T / 2; u += gridDim.x * NWV) unit_attn_a4(p, u, vl, dummy);
}
__global__ void __launch_bounds__(512, 2) k_mega(Params p) {
  extern __shared__ __attribute__((aligned(16))) char lds[];
  const ldsb_t ldsl = (ldsb_t)lds;
  volatile LAS unsigned* xbw = (volatile LAS unsigned*)(lds + LDS_BYTES - 16);
  if (threadIdx.x == 0) { xbw[0] = 0u; xbw[1] = 0u; xbw[2] = 0u; xbw[3] = 0u; }
  __syncthreads();
  XcdBarrier bar = xcd_barrier_post(WSP(unsigned, OFF_BAR), xbw);
  ph_prep(p); ph_transposes(p, lds);
#if PROBE == 1
  ph_prep(p); ph_transposes(p, lds);
#endif
  xcd_barrier(bar);
#if PROBE == 20
  xcd_barrier(bar);
#endif
  ph_gemm1(p, ldsl);
#if PROBE == 2
  ph_gemm1(p, ldsl);
#endif
  xcd_barrier(bar);
#if PROBE == 20
  xcd_barrier(bar);
#endif
#if PROBE == 3
  ph_topk(p, lds);
#endif
#if PROBE == 4
  ph_attn_blk(p, lds, (bf16_t*)p.out + (size_t)32 * MiB);
#endif
  ph_topk(p, lds); ph_attn_blk(p, lds);
  xcd_barrier(bar);
#if PROBE == 20
  xcd_barrier(bar);
#endif
#if PROBE == 5 || PROBE == 41 || PROBE == 42
  ph_attn_a(p, lds, WSP(bf16_t, OFF_IQ)); __syncthreads();
#endif
#if PROBE == 6
  ph_gates(p, ldsl);
#endif
#if PROBE == 21
  ph_gates_probe<1>(p, ldsl);
#endif
#if PROBE == 22
  ph_gates_probe<2>(p, ldsl);
#endif
#if PROBE == 23
  ph_gates_probe<3>(p, ldsl);
#endif
  ph_gates(p, ldsl); ph_attn_a(p, lds); ph_mergeb(p);
#if PROBE == 14
  ph_mergeb(p);
#endif
  xcd_barrier(bar);
#if PROBE == 20
  xcd_barrier(bar);
#endif
  ph_branch(p, ldsl);
#if PROBE == 7
  ph_branch(p, ldsl);
#endif
  xcd_barrier(bar);
#if PROBE == 20
  xcd_barrier(bar);
#endif
  ph_out(p, ldsl);
#if PROBE == 8
  ph_out(p, ldsl);
#endif
  xcd_barrier(bar);
#if PROBE == 20
  xcd_barrier(bar);
#endif
#if PROBE == 13
  ph_route(p, lds, true);
#endif
  ph_route(p, lds);
  xcd_barrier(bar);
#if PROBE == 20
  xcd_barrier(bar);
#endif
  ph_up(p, ldsl);
#if PROBE == 9
  ph_up(p, ldsl);
#endif
  xcd_barrier(bar);
#if PROBE == 20
  xcd_barrier(bar);
#endif
  ph_down(p, ldsl);
#if PROBE == 10
  ph_down(p, ldsl);
#endif
  xcd_barrier(bar);
#if PROBE == 20
  xcd_barrier(bar);
#endif
#if PROBE == 15
  ph_final(p, true);
#endif
  ph_final(p);
}

extern "C" void kernel_launch(void* const* d_in, const int* in_sizes, int n_in, void* d_out, int out_size, void* d_ws, size_t ws_size, hipStream_t stream) {
  (void)in_sizes; (void)n_in; (void)out_size;
  if (ws_size < OFF_END) { fprintf(stderr, "workspace too small: %zu < %zu\n", ws_size, (size_t)OFF_END); return; }
  Params p{};
  p.x = (const float*)d_in[0]; p.mem = (const float*)d_in[1]; p.g_mix = (const float*)d_in[2]; p.g_mem = (const float*)d_in[3];
  p.w_in = (const float*)d_in[4]; p.w_mem_kv = (const float*)d_in[5]; p.w_gate = (const float*)d_in[6]; p.b_gate = (const float*)d_in[7];
  p.w_branch = (const float*)d_in[8]; p.w_out = (const float*)d_in[9]; p.g_ffn = (const float*)d_in[10]; p.w_group = (const float*)d_in[11];
  p.b_group = (const float*)d_in[12]; p.w_sub = (const float*)d_in[13]; p.b_sub = (const float*)d_in[14]; p.w1 = (const float*)d_in[15];
  p.w3 = (const float*)d_in[16]; p.w2 = (const float*)d_in[17]; p.g_final = (const float*)d_in[18];
  p.out = (float*)d_out; p.ws = (char*)d_ws;
  static int grid = 0;
  if (!grid) {
    int dev = 0, cus = 0, per_cu = 0;
    (void)hipGetDevice(&dev);
    (void)hipDeviceGetAttribute(&cus, hipDeviceAttributeMultiprocessorCount, dev);
    (void)hipFuncSetAttribute((const void*)k_mega, hipFuncAttributeMaxDynamicSharedMemorySize, LDS_BYTES);
    (void)hipOccupancyMaxActiveBlocksPerMultiprocessor(&per_cu, k_mega, NTH, LDS_BYTES);
    if (per_cu > 1) per_cu = 1;
    if (per_cu < 1) per_cu = 1;
    grid = cus * per_cu;
  }
  (void)hipMemsetAsync(d_ws, 0, 32768, stream);
  k_mega<<<grid, NTH, LDS_BYTES, stream>>>(p);
}
```
